# Optimizing an MI355X kernel written in HIP

```python
import jax, jax.numpy as jnp
from jax import lax
import numpy as np

D_MODEL = 1024
BATCH = 4
SEQ = 8192
DEPTH = 4

EPS = 1e-6
D_FF = 2816
MLA_HEADS = 8
MLA_Q_LORA = 256
MLA_KV_LORA = 128
MLA_NOPE = 64
MLA_ROPE = 32
MLA_V = 64
MLA_QK = MLA_NOPE + MLA_ROPE
ROPE_BASE = 10000.0
ATTN_BLOCK = 128
GDN_HEADS = 8
GDN_DK = 64
GDN_DV = 64
GDN_CONV = 4
GDN_CHUNK = 64
GDN_QKV_W = GDN_HEADS * (2 * GDN_DK + GDN_DV)
SG_GROUPS = 8
SG_WIDTH = 2048
SG_CHUNK = 128
AB_WIDTHS = (MLA_Q_LORA, MLA_KV_LORA, MLA_ROPE, GDN_QKV_W, GDN_HEADS * GDN_DV, GDN_HEADS, GDN_HEADS)
IN_AB = sum(AB_WIDTHS)
MIX_AB = MLA_HEADS * MLA_V + GDN_HEADS * GDN_DV

kernel_name = "hybrid_mla_gdn_sgmlp_macaron"


def rms_norm(x, w):
    xf = x.astype(jnp.float32)
    y = xf * lax.rsqrt(jnp.mean(xf * xf, axis=-1, keepdims=True) + EPS)
    return (y * w.astype(jnp.float32)).astype(x.dtype)


def l2_norm(x):
    return x * lax.rsqrt(jnp.sum(x * x, axis=-1, keepdims=True) + EPS)


def swiglu(h, w_gate, w_up, w_down):
    return (jax.nn.silu(h @ w_gate) * (h @ w_up)) @ w_down


def rope_tables(positions):
    inv_freq = ROPE_BASE ** (-jnp.arange(0, MLA_ROPE, 2, dtype=jnp.float32) / MLA_ROPE)
    ang = positions.astype(jnp.float32)[..., None] * inv_freq
    return jnp.cos(ang)[:, :, None, :], jnp.sin(ang)[:, :, None, :]


def apply_rope(t, cos, sin):
    half = MLA_ROPE // 2
    t_nope, r1, r2 = t[..., :MLA_NOPE], t[..., MLA_NOPE:MLA_NOPE + half], t[..., MLA_NOPE + half:]
    c, s = cos.astype(t.dtype), sin.astype(t.dtype)
    return jnp.concatenate([t_nope, r1 * c - r2 * s, r2 * c + r1 * s], axis=-1)


def causal_block_attention(q, k, v):
    b, s, h, dq = q.shape
    dv = v.shape[-1]
    nb = s // ATTN_BLOCK
    scale = dq ** -0.5
    qb = q.astype(jnp.float32).reshape(b, nb, ATTN_BLOCK, h, dq).transpose(1, 0, 3, 2, 4)
    kh = k.astype(jnp.float32).transpose(0, 2, 1, 3)
    vh = v.astype(jnp.float32).transpose(0, 2, 1, 3)
    key_idx = jnp.arange(s)

    def one_block(args):
        q_blk, blk = args
        sc = jnp.einsum('bhqd,bhkd->bhqk', q_blk, kh) * scale
        q_idx = blk * ATTN_BLOCK + jnp.arange(ATTN_BLOCK)
        sc = jnp.where(key_idx[None, :] <= q_idx[:, None], sc, -jnp.inf)
        p = jax.nn.softmax(sc, axis=-1)
        return jnp.einsum('bhqk,bhkd->bhqd', p, vh)

    o = lax.map(one_block, (qb, jnp.arange(nb)))
    return o.transpose(1, 0, 3, 2, 4).reshape(b, s, h * dv).astype(v.dtype)


def causal_short_conv(x, w):
    kw, s = w.shape[0], x.shape[1]
    xp = jnp.pad(x, ((0, 0), (kw - 1, 0), (0, 0)))
    return sum(xp[:, j:j + s] * w[j] for j in range(kw))


def gated_delta_rule(q, k, v, beta, g):
    b, s, h, dk = q.shape
    dv = v.shape[-1]
    c = GDN_CHUNK
    n = s // c

    def chunks(t):
        return t.reshape(b, n, c, h, -1).transpose(0, 3, 1, 2, 4)

    q, k, v = chunks(q), chunks(k), chunks(v)
    beta = beta.reshape(b, n, c, h).transpose(0, 3, 1, 2)
    gc = jnp.cumsum(g.reshape(b, n, c, h).transpose(0, 3, 1, 2), axis=-1)
    tril = jnp.tril(jnp.ones((c, c), bool))
    strict = jnp.tril(jnp.ones((c, c), bool), -1)
    decay = jnp.exp(jnp.where(tril, gc[..., :, None] - gc[..., None, :], -jnp.inf))
    kb = k * beta[..., None]
    vb = v * beta[..., None]
    a = jnp.where(strict, jnp.einsum('bhnid,bhnjd->bhnij', kb, k) * decay, 0.0) + jnp.eye(c, dtype=jnp.float32)
    rhs = jnp.concatenate([vb, kb * jnp.exp(gc)[..., None]], axis=-1)
    sol = lax.linalg.triangular_solve(a, rhs, left_side=True, lower=True, unit_diagonal=True)
    u, w = sol[..., :dv], sol[..., dv:]
    attn = jnp.einsum('bhnid,bhnjd->bhnij', q, k) * decay
    q_dec = q * jnp.exp(gc)[..., None]
    g_last = gc[..., -1:]
    k_tail = k * jnp.exp(g_last - gc)[..., None]

    def step(state, xs):
        u_i, w_i, a_i, qd_i, kt_i, gl_i = xs
        v_new = u_i - jnp.einsum('bhcd,bhde->bhce', w_i, state)
        o_i = jnp.einsum('bhcd,bhde->bhce', qd_i, state) + jnp.einsum('bhcj,bhje->bhce', a_i, v_new)
        state = state * jnp.exp(gl_i)[..., None] + jnp.einsum('bhcd,bhce->bhde', kt_i, v_new)
        return state, o_i

    xs = tuple(jnp.moveaxis(t, 2, 0) for t in (u, w, attn, q_dec, k_tail, g_last))
    state0 = jnp.zeros((b, h, dk, dv), jnp.float32)
    _, o = lax.scan(step, state0, xs)
    return o.transpose(1, 0, 3, 2, 4).reshape(b, s, h, dv)


def mixer_mla_gdn(h, cos, sin, w_in, q_norm, w_q_b, kv_norm, w_kv_b, qk_norm_q, qk_norm_k,
                  conv_w, a_log, dt_bias, out_norm, w_out):
    b, s, _ = h.shape
    idx = [int(i) for i in np.cumsum(AB_WIDTHS)[:-1]]
    c_q, c_kv, k_r, qkv, z, b_logit, a_logit = jnp.split(h @ w_in, idx, axis=-1)
    q = (rms_norm(c_q, q_norm) @ w_q_b).reshape(b, s, MLA_HEADS, MLA_QK)
    kv = (rms_norm(c_kv, kv_norm) @ w_kv_b).reshape(b, s, MLA_HEADS, MLA_NOPE + MLA_V)
    k_nope, v = kv[..., :MLA_NOPE], kv[..., MLA_NOPE:]
    k = jnp.concatenate([k_nope, jnp.broadcast_to(k_r[:, :, None, :], (b, s, MLA_HEADS, MLA_ROPE))], axis=-1)
    q = apply_rope(rms_norm(q, qk_norm_q), cos, sin)
    k = apply_rope(rms_norm(k, qk_norm_k), cos, sin)
    y_mla = causal_block_attention(q, k, v)
    qkv = jax.nn.silu(causal_short_conv(qkv, conv_w)).astype(jnp.float32)
    gq, gk, gv = jnp.split(qkv, [GDN_HEADS * GDN_DK, 2 * GDN_HEADS * GDN_DK], axis=-1)
    gq = l2_norm(gq.reshape(b, s, GDN_HEADS, GDN_DK)) * (GDN_DK ** -0.5)
    gk = l2_norm(gk.reshape(b, s, GDN_HEADS, GDN_DK))
    gv = gv.reshape(b, s, GDN_HEADS, GDN_DV)
    beta = jax.nn.sigmoid(b_logit.astype(jnp.float32))
    g = -jnp.exp(a_log.astype(jnp.float32)) * jax.nn.softplus(a_logit.astype(jnp.float32) + dt_bias.astype(jnp.float32))
    o = gated_delta_rule(gq, gk, gv, beta, g).astype(h.dtype)
    o = rms_norm(o, out_norm) * jax.nn.silu(z.reshape(b, s, GDN_HEADS, GDN_DV))
    y = jnp.concatenate([y_mla, o.reshape(b, s, GDN_HEADS * GDN_DV)], axis=-1)
    return y @ w_out


def mixer_spatial_gating(h, w_in, v_norm, w_s, b_s, w_out):
    b, s, _ = h.shape
    n = s // SG_CHUNK
    cg = SG_WIDTH // SG_GROUPS
    u, v = jnp.split(jax.nn.gelu(h @ w_in, approximate=False), 2, axis=-1)
    v = rms_norm(v.reshape(b, n, SG_CHUNK, SG_GROUPS, cg), v_norm.reshape(SG_GROUPS, cg))
    w_causal = jnp.where(jnp.tril(jnp.ones((SG_CHUNK, SG_CHUNK), bool)), w_s, 0)
    gate = jnp.einsum('gij,bnjgc->bnigc', w_causal, v) + b_s.T[:, :, None]
    return (u * gate.reshape(b, s, SG_WIDTH)) @ w_out


def setup_inputs(seed: int = 0) -> dict:
    key = jax.random.key(seed)
    ks = jax.random.split(key, 24)
    ne = (DEPTH + 1) // 2
    no = DEPTH // 2
    f32 = jnp.float32

    def nrm(k, shape, fan_in):
        return jax.random.normal(k, shape, f32) * (fan_in ** -0.5)

    def gain(k, shape, sd=0.05):
        return 1.0 + sd * jax.random.normal(k, shape, f32)

    dt = jnp.exp(jax.random.uniform(ks[15], (ne, GDN_HEADS), f32, np.log(0.001), np.log(0.1)))
    return {
        "x": jax.random.normal(ks[0], (BATCH, SEQ, D_MODEL), f32),
        "positions": (jnp.arange(SEQ, dtype=jnp.int32)[None, :]
                      + jax.random.randint(ks[1], (BATCH, 1), 0, 1024, jnp.int32)),
        "norm_w": gain(ks[2], (DEPTH, 3, D_MODEL)),
        "ffn_w_gate": nrm(ks[3], (DEPTH, 2, D_MODEL, D_FF), D_MODEL),
        "ffn_w_up": nrm(ks[4], (DEPTH, 2, D_MODEL, D_FF), D_MODEL),
        "ffn_w_down": nrm(ks[5], (DEPTH, 2, D_FF, D_MODEL), D_FF),
        "ab_w_in": nrm(ks[6], (ne, D_MODEL, IN_AB), D_MODEL),
        "mla_q_norm": gain(ks[7], (ne, MLA_Q_LORA)),
        "mla_w_q_b": nrm(ks[8], (ne, MLA_Q_LORA, MLA_HEADS * MLA_QK), MLA_Q_LORA),
        "mla_kv_norm": gain(ks[9], (ne, MLA_KV_LORA)),
        "mla_w_kv_b": nrm(ks[10], (ne, MLA_KV_LORA, MLA_HEADS * (MLA_NOPE + MLA_V)), MLA_KV_LORA),
        "mla_qk_norm_q": gain(ks[11], (ne, MLA_QK)),
        "mla_qk_norm_k": gain(ks[12], (ne, MLA_QK)),
        "gdn_conv_w": nrm(ks[13], (ne, GDN_CONV, GDN_QKV_W), GDN_CONV),
        "gdn_a_log": jnp.log(jax.random.uniform(ks[14], (ne, GDN_HEADS), f32, 1.0, 16.0)),
        "gdn_dt_bias": jnp.log(jnp.expm1(dt)),
        "gdn_out_norm": gain(ks[16], (ne, GDN_DV)),
        "ab_w_out": nrm(ks[17], (ne, MIX_AB, D_MODEL), MIX_AB),
        "sg_w_in": nrm(ks[18], (no, D_MODEL, 2 * SG_WIDTH), D_MODEL),
        "sg_v_norm": gain(ks[19], (no, SG_WIDTH)),
        "sg_w_s": nrm(ks[20], (no, SG_GROUPS, SG_CHUNK, SG_CHUNK), SG_CHUNK),
        "sg_b_s": gain(ks[21], (no, SG_GROUPS, SG_CHUNK), 0.1),
        "sg_w_out": nrm(ks[22], (no, SG_WIDTH, D_MODEL), SG_WIDTH),
    }


def reference(x, positions, norm_w, ffn_w_gate, ffn_w_up, ffn_w_down, ab_w_in, mla_q_norm, mla_w_q_b,
              mla_kv_norm, mla_w_kv_b, mla_qk_norm_q, mla_qk_norm_k, gdn_conv_w, gdn_a_log, gdn_dt_bias,
              gdn_out_norm, ab_w_out, sg_w_in, sg_v_norm, sg_w_s, sg_b_s, sg_w_out):
    cos, sin = rope_tables(positions)
    for l in range(DEPTH):
        i = l // 2
        x = x + 0.5 * swiglu(rms_norm(x, norm_w[l, 0]), ffn_w_gate[l, 0], ffn_w_up[l, 0], ffn_w_down[l, 0])
        h = rms_norm(x, norm_w[l, 1])
        if l % 2 == 0:
            x = x + mixer_mla_gdn(h, cos, sin, ab_w_in[i], mla_q_norm[i], mla_w_q_b[i], mla_kv_norm[i],
                                  mla_w_kv_b[i], mla_qk_norm_q[i], mla_qk_norm_k[i], gdn_conv_w[i],
                                  gdn_a_log[i], gdn_dt_bias[i], gdn_out_norm[i], ab_w_out[i])
        else:
            x = x + mixer_spatial_gating(h, sg_w_in[i], sg_v_norm[i], sg_w_s[i], sg_b_s[i], sg_w_out[i])
        x = x + 0.5 * swiglu(rms_norm(x, norm_w[l, 2]), ffn_w_gate[l, 1], ffn_w_up[l, 1], ffn_w_down[l, 1])
    return x
```

```cpp
#define SKIP_MIX 0
#ifndef PROBE_RES
#define PROBE_RES 0
#endif
#ifndef PROBE_INP
#define PROBE_INP 0
#endif
#ifndef PROBE_SYNC
#define PROBE_SYNC 0
#endif
#ifndef PROBE_MISC
#define PROBE_MISC 0
#endif
#ifndef PROBE_CONV
#define PROBE_CONV 0
#endif
#ifndef PROBE_E4
#define PROBE_E4 0
#endif
#ifndef PROBE_SG
#define PROBE_SG 0
#endif
#ifndef PROBE_G1
#define PROBE_G1 0
#endif
#define SKIP_EVEN 0
#define ZERO_GDN 0
#define ZERO_ATT 0
#include <hip/hip_runtime.h>
#include <hip/hip_cooperative_groups.h>
#include <cstdio>
#include <cstdint>
namespace cg = cooperative_groups;

#define LAS __attribute__((address_space(3)))
typedef unsigned short bf16;
typedef short bf16x8 __attribute__((ext_vector_type(8)));
typedef float f32x2 __attribute__((ext_vector_type(2)));
typedef float f32x4 __attribute__((ext_vector_type(4)));
typedef float f32x16 __attribute__((ext_vector_type(16)));
typedef unsigned u32x4 __attribute__((ext_vector_type(4)));
typedef unsigned u32x2 __attribute__((ext_vector_type(2)));

constexpr int T = 32768, DM = 1024, FF = 2816, SEQ = 8192, NB = 4;
constexpr float EPS = 1e-6f;
constexpr int LDS_BYTES = 147456;
constexpr size_t MiB = 1u << 20;
constexpr size_t WS_CTL = 0, WS_W = 8 * MiB, WS_XB = 56 * MiB, WS_ACT = 120 * MiB, WS_END = 512 * MiB;
constexpr size_t W_1A = 0, W_2A = 11534336, W_1B = 17301504, W_2B = 28835840, W_MIX = 34603008;
constexpr size_t W_IN = W_MIX, W_QB = W_MIX + 5242880, W_KVB = W_QB + 393216, W_OUT = W_KVB + 524288;
constexpr size_t W_SIN = W_MIX, W_SOUT = W_MIX + 8388608, W_SS = W_SOUT + 4194304;
constexpr size_t A_H = WS_ACT;
constexpr size_t A_QKV = WS_ACT, A_P01 = WS_ACT + 96 * MiB;
constexpr size_t A_U = WS_ACT, A_WW = WS_ACT + 32 * MiB, A_Y = WS_ACT + 64 * MiB;
constexpr size_t A_Z = WS_ACT + 128 * MiB, A_Q = WS_ACT + 160 * MiB, A_KP = WS_ACT + 208 * MiB, A_V = WS_ACT + 256 * MiB;
constexpr size_t A_GQ = WS_ACT + 288 * MiB, A_GK = WS_ACT + 320 * MiB, A_GV = WS_ACT + 352 * MiB;
constexpr size_t A_UV = WS_ACT, A_UG = WS_ACT + 256 * MiB;
constexpr int C_SSX = 0, C_SSQ = 524288, C_SSKV = 655360, C_BAR = 1048576, C_QCTR = 1048576 + 4096;
constexpr size_t A_SSV = WS_ACT + 384 * MiB;
constexpr size_t A_BETA = WS_ACT + 384 * MiB, A_GG = WS_ACT + 385 * MiB, A_GC = WS_ACT + 386 * MiB;

struct Params { const void* in[23]; float* out; unsigned char* ws; };

typedef __bf16 bf16x2_t __attribute__((ext_vector_type(2)));
__device__ __forceinline__ unsigned pk2(float lo, float hi) { const f32x2 v = {lo, hi}; const bf16x2_t b = __builtin_convertvector(v, bf16x2_t); return __builtin_bit_cast(unsigned, b); }
__device__ __forceinline__ float bflo(unsigned w) { return __uint_as_float(w << 16); }
__device__ __forceinline__ float bfhi(unsigned w) { return __uint_as_float(w & 0xffff0000u); }
__device__ __forceinline__ float bf2f(unsigned short b) { return __uint_as_float(((unsigned)b) << 16); }
__device__ __forceinline__ float wave_sum(float v) {
#pragma unroll
    for (int o = 1; o < 64; o <<= 1) v += __shfl_xor(v, o);
    return v;
}
__device__ __forceinline__ float sigmoidf_(float x) { return __builtin_amdgcn_rcpf(1.f + __expf(-x)); }
__device__ __forceinline__ float siluf_(float x) { return x * __builtin_amdgcn_rcpf(1.f + __expf(-x)); }
__device__ __forceinline__ void unpack8(const u32x4 v, float* f) {
    f[0] = bflo(v.x); f[1] = bfhi(v.x); f[2] = bflo(v.y); f[3] = bfhi(v.y); f[4] = bflo(v.z); f[5] = bfhi(v.z); f[6] = bflo(v.w); f[7] = bfhi(v.w);
}
__device__ __forceinline__ u32x4 pack8(const float* f) { u32x4 o; o.x = pk2(f[0], f[1]); o.y = pk2(f[2], f[3]); o.z = pk2(f[4], f[5]); o.w = pk2(f[6], f[7]); return o; }
__device__ __forceinline__ int otid() { int t = threadIdx.x; asm volatile("" : "+v"(t)); return t; }
template <class P_> __device__ __forceinline__ P_* opq(P_* q) { asm volatile("" : "+s"(q)); return q; }
__device__ __forceinline__ float sum16(const float* s) { const f32x4 a = *(const f32x4*)s, b = *(const f32x4*)(s + 4), c = *(const f32x4*)(s + 8), d = *(const f32x4*)(s + 12);
    return ((a[0] + a[1]) + (a[2] + a[3])) + ((b[0] + b[1]) + (b[2] + b[3])) + ((c[0] + c[1]) + (c[2] + c[3])) + ((d[0] + d[1]) + (d[2] + d[3])); }
__device__ __forceinline__ float sum4(const float* s) { const f32x4 a = *(const f32x4*)s; return (a[0] + a[1]) + (a[2] + a[3]); }
#define LDS_WAIT() asm volatile("s_waitcnt lgkmcnt(0)" ::: "memory")
__device__ __forceinline__ bf16x8 lds8(LAS const unsigned char* base, int row, int pitchB, int colElem) {
    return *(LAS const bf16x8*)(base + row * pitchB + colElem * 2);
}
__device__ __forceinline__ f32x4 mfma16(bf16x8 a, bf16x8 b, f32x4 c) { return __builtin_amdgcn_mfma_f32_16x16x32_bf16(a, b, c, 0, 0, 0); }

namespace pg8 {
constexpr int BM = 256, BK = 64, HALF = 128, HTB = HALF * BK * 2, STAGE_BYTES = 8 * HTB, NXCD = 8, WGM = 8;
__host__ __device__ __forceinline__ int lds_byte(int r, int c) { const int st = (r >> 4) * 2 + (c >> 5), rr = r & 15, cc = c & 31, ob = rr * 64 + cc * 2; return st * 1024 + (ob ^ (((ob >> 9) & 1) << 5)); }
__host__ __device__ __forceinline__ void stage_rc(int b, int& R, int& C) { const int st = b / 1024, sb = b % 1024, swz = sb ^ (((sb >> 9) & 1) << 5); R = (st >> 1) * 16 + swz / 64; C = (st & 1) * 32 + (swz % 64) / 2; }
__host__ __device__ __forceinline__ int perm32(int rho) { const int n = rho >> 4, i = rho & 15; return 8 * (i >> 2) + 4 * n + (i & 3); }
struct Unit { int pm, pn; };
struct Gemm { const bf16* A; const bf16* Bt; int M, N, K, lda; };
struct StaticOrder {
    int nM, nN, nwg, G, c;
    __device__ void init(int M, int N, int G_, int c_) { nM = M / BM; nN = N / BM; nwg = nM * nN; G = G_; c = c_; }
    __device__ bool next(int i, Unit& u) const {
        const long L = (long)i * G + c; if (L >= nwg) return false;
        int wgid = (int)L; { const int q = nwg / NXCD, r = nwg % NXCD, xcd = wgid % NXCD, off = wgid / NXCD; wgid = (xcd < r ? xcd * (q + 1) : r * (q + 1) + (xcd - r) * q) + off; }
        const int nig = WGM * nN, gid = wgid / nig, fm = gid * WGM, gsz = (nM - fm) < WGM ? (nM - fm) : WGM;
        u.pm = fm + ((wgid % nig) % gsz); u.pn = (wgid % nig) / gsz; return true;
    }
};
template <class Epi>
__device__ __forceinline__ void gemm_phase(LAS unsigned char* lds, const Gemm g, const StaticOrder& S, const Epi& E) {
    const int tid = otid(), wid = __builtin_amdgcn_readfirstlane(tid >> 6), lane = tid & 63, wr = wid >> 2, wc = wid & 3, fr = lane & 15, fq = lane >> 4;
    int K = g.K, lda = g.lda; asm volatile("" : "+s"(K), "+s"(lda)); const int nt = K / BK;
    unsigned voffA[2], voffB[2];
#pragma unroll
    for (int i = 0; i < 2; ++i) { int R, C; stage_rc(tid * 16 + i * 8192, R, C); const int Rb = (R & ~31) + perm32(R & 31);
        voffA[i] = (unsigned)(R * lda + C) * 2u; voffB[i] = (unsigned)(Rb * K + C) * 2u; }
    const size_t kstep = (size_t)(BK * 2);
    const size_t hstepA = (size_t)HALF * lda * 2, hstepB = (size_t)HALF * K * 2;
    const size_t tstepA = 2 * hstepA, tstepB = 2 * hstepB;
    const unsigned ldsw = (unsigned)wid * 1024u;
    const int aoff = lds_byte(wr * 64 + fr, fq * 8), boff = lds_byte(wc * 32 + fr, fq * 8);
#define PG8_SA(b, h) (((b) * 2 + (h)) * HTB)
#define PG8_SB(b, h) ((4 + (b) * 2 + (h)) * HTB)
#define PG8_STAGE(bufoff, gbase, voff) do { _Pragma("unroll") for (int _i = 0; _i < 2; ++_i) \
        __builtin_amdgcn_global_load_lds((const unsigned*)((const char*)(gbase) + (voff)[_i]), (LAS unsigned*)(lds + (bufoff) + ldsw + _i * 8192), 16, 0, 0); } while (0)
#define PG8_LDA(dst, b, h) do { _Pragma("unroll") for (int m = 0; m < 4; ++m) _Pragma("unroll") for (int k = 0; k < 2; ++k) dst[m][k] = *(const LAS bf16x8*)(lds + PG8_SA(b, h) + aoff + m * 2048 + k * 1024); } while (0)
#define PG8_LDB(dst, b, h) do { _Pragma("unroll") for (int n = 0; n < 2; ++n) _Pragma("unroll") for (int k = 0; k < 2; ++k) dst[n][k] = *(const LAS bf16x8*)(lds + PG8_SB(b, h) + boff + n * 2048 + k * 1024); } while (0)
#define PG8_MMA(ai, bj, At, Bt) do { __builtin_amdgcn_s_setprio(1); _Pragma("unroll") for (int m = 0; m < 4; ++m) _Pragma("unroll") for (int n = 0; n < 2; ++n) _Pragma("unroll") for (int k = 0; k < 2; ++k) \
        acc[ai][bj][m][n] = __builtin_amdgcn_mfma_f32_16x16x32_bf16(Bt[n][k], At[m][k], acc[ai][bj][m][n], 0, 0, 0); __builtin_amdgcn_s_setprio(0); } while (0)
#define PG8_WAIT_V(n) asm volatile("s_waitcnt vmcnt(" #n ")" ::: "memory")
#define PG8_WAIT_L(n) asm volatile("s_waitcnt lgkmcnt(" #n ")" ::: "memory")
#define PG8_BAR __builtin_amdgcn_s_barrier()
#define PG8_SCHED __builtin_amdgcn_sched_barrier(0)
    Unit cur, nxt; int ui = 0; int cpm = -1;
    if (!S.next(0, cur)) return;
    f32x4 acc[2][2][4][2];
#pragma unroll
    for (int a = 0; a < 2; ++a)
#pragma unroll
        for (int b = 0; b < 2; ++b)
#pragma unroll
            for (int m = 0; m < 4; ++m)
#pragma unroll
                for (int n = 0; n < 2; ++n) acc[a][b][m][n] = (f32x4){0.f, 0.f, 0.f, 0.f};
    bf16x8 At[4][2], B0[2][2], B1[2][2];
    const char* cA = (const char*)g.A + (size_t)cur.pm * tstepA; const char* cB = (const char*)g.Bt + (size_t)cur.pn * tstepB;
    PG8_STAGE(PG8_SB(0, 0), cB, voffB); PG8_STAGE(PG8_SB(0, 1), cB + hstepB, voffB); PG8_STAGE(PG8_SA(0, 0), cA, voffA); PG8_STAGE(PG8_SA(0, 1), cA + hstepA, voffA);
    if (wr == 1) PG8_BAR;
    PG8_WAIT_V(2); PG8_BAR;
    PG8_STAGE(PG8_SB(1, 0), cB + kstep, voffB); PG8_STAGE(PG8_SA(1, 0), cA + kstep, voffA); PG8_STAGE(PG8_SB(1, 1), cB + hstepB + kstep, voffB);
    PG8_WAIT_V(6); PG8_BAR;
    for (;;) {
        const bool has_next = S.next(ui + 1, nxt);
        const char* nA = has_next ? (const char*)g.A + (size_t)nxt.pm * tstepA : cA; const char* nB = has_next ? (const char*)g.Bt + (size_t)nxt.pn * tstepB : cB;
        for (int t = 0; t < nt; t += 2) {
            const bool last = (t == nt - 2);
            const char* a1 = cA + (size_t)(t + 1) * kstep;
            const char* a2 = last ? nA : cA + (size_t)(t + 2) * kstep; const char* b2 = last ? nB : cB + (size_t)(t + 2) * kstep;
            const char* a3 = a2 + kstep; const char* b3 = b2 + kstep;
            PG8_LDB(B0, 0, 0); PG8_LDB(B1, 0, 1); PG8_SCHED; PG8_LDA(At, 0, 0); PG8_STAGE(PG8_SA(1, 1), a1 + hstepA, voffA);
            PG8_WAIT_V(8); PG8_WAIT_L(0); PG8_BAR; PG8_MMA(0, 0, At, B0); PG8_MMA(0, 1, At, B1); PG8_BAR; PG8_SCHED;
            PG8_LDA(At, 0, 1); PG8_STAGE(PG8_SB(0, 0), b2, voffB); PG8_STAGE(PG8_SB(0, 1), b2 + hstepB, voffB); PG8_STAGE(PG8_SA(0, 0), a2, voffA);
            PG8_WAIT_V(8); PG8_WAIT_L(0); PG8_BAR; PG8_MMA(1, 0, At, B0); PG8_MMA(1, 1, At, B1); PG8_BAR; PG8_SCHED;
            PG8_LDB(B0, 1, 0); PG8_LDB(B1, 1, 1); PG8_SCHED; PG8_LDA(At, 1, 0); PG8_STAGE(PG8_SA(0, 1), a2 + hstepA, voffA);
            PG8_WAIT_V(8); PG8_WAIT_L(0); PG8_BAR; PG8_MMA(0, 0, At, B0); PG8_MMA(0, 1, At, B1); PG8_BAR; PG8_SCHED;
            PG8_LDA(At, 1, 1); PG8_STAGE(PG8_SB(1, 0), b3, voffB); PG8_STAGE(PG8_SB(1, 1), b3 + hstepB, voffB); PG8_STAGE(PG8_SA(1, 0), a3, voffA);
            PG8_WAIT_V(8); PG8_WAIT_L(0); PG8_BAR; PG8_MMA(1, 0, At, B0); PG8_MMA(1, 1, At, B1); PG8_BAR; PG8_SCHED;
        }
        if (wr == 0) PG8_BAR;
        if constexpr (Epi::RS_TAB) {
            if (cur.pm != cpm) {
                const int trow = tid >> 1, thalf = tid & 1;
                const float* sp = E.ss + (size_t)(cur.pm * BM + trow) * 16 + thalf * 8;
                const f32x4 s0 = *(const f32x4*)sp, s1 = *(const f32x4*)(sp + 4);
                float s = ((s0[0] + s0[1]) + (s0[2] + s0[3])) + ((s1[0] + s1[1]) + (s1[2] + s1[3]));
                s += __shfl_xor(s, 1);
                if (thalf == 0) *(LAS float*)(lds + STAGE_BYTES + trow * 4) = rsqrtf(s * (1.f / 1024.f) + EPS);
                PG8_WAIT_L(0); PG8_BAR;
                cpm = cur.pm;
            }
        }
        E(acc, cur, wr, wc, fr, fq, (LAS const float*)(lds + STAGE_BYTES));
        if (!has_next) break;
#pragma unroll
        for (int a = 0; a < 2; ++a)
#pragma unroll
            for (int b = 0; b < 2; ++b)
#pragma unroll
                for (int m = 0; m < 4; ++m)
#pragma unroll
                    for (int n = 0; n < 2; ++n) acc[a][b][m][n] = (f32x4){0.f, 0.f, 0.f, 0.f};
        cur = nxt; cA = nA; cB = nB; ++ui;
        if (wr == 1) PG8_BAR;
    }
    PG8_WAIT_V(0);
    PG8_BAR;
#undef PG8_SA
#undef PG8_SB
#undef PG8_STAGE
#undef PG8_LDA
#undef PG8_LDB
#undef PG8_MMA
#undef PG8_WAIT_V
#undef PG8_WAIT_L
#undef PG8_BAR
#undef PG8_SCHED
}
typedef f32x4 Acc[2][2][4][2];
__device__ __forceinline__ f32x2 gelu_pk(f32x2 v) {
    const f32x2 av = __builtin_elementwise_abs(v), d = av * 0.2316418882f + 1.0f;
    f32x2 t; t.x = __builtin_amdgcn_rcpf(d.x); t.y = __builtin_amdgcn_rcpf(d.y);
    f32x2 q = t * 0.5307027145f + (-0.7265760135f); q = q * t + 0.7107068705f; q = q * t + (-0.142248368f); q = q * t + 0.127414796f; q = q * t;
    const f32x2 s = (v * v) * (-0.72134752044f);
    f32x2 e; e.x = __builtin_amdgcn_exp2f(s.x); e.y = __builtin_amdgcn_exp2f(s.y);
    const f32x2 m = v * (q * e), r = v - m;
    f32x2 o; o.x = v.x < 0.f ? m.x : r.x; o.y = v.y < 0.f ? m.y : r.y; return o;
}

template <int NS> __device__ __forceinline__ void row_scales(const float* ss, int row0, int fq, float inv_n, float (&rs)[8]) {
    if constexpr (NS == 16) {
        f32x4 v[8];
#pragma unroll
        for (int i = 0; i < 8; ++i) v[i] = *(const f32x4*)(ss + (size_t)(row0 + (i >> 2) * HALF + (i & 3) * 16) * 16 + 4 * fq);
#pragma unroll
        for (int i = 0; i < 8; ++i) { float s = (v[i][0] + v[i][1]) + (v[i][2] + v[i][3]); s += __shfl_xor(s, 16); s += __shfl_xor(s, 32); rs[i] = rsqrtf(s * inv_n + EPS); }
    } else {
        float v[8];
#pragma unroll
        for (int i = 0; i < 8; ++i) v[i] = ss[(size_t)(row0 + (i >> 2) * HALF + (i & 3) * 16) * 4 + fq];
#pragma unroll
        for (int i = 0; i < 8; ++i) { float s = v[i]; s += __shfl_xor(s, 16); s += __shfl_xor(s, 32); rs[i] = rsqrtf(s * inv_n + EPS); }
    }
}
struct EpiSwiglu {
    static constexpr bool RS_TAB = true;
    bf16* H; const float* ss;
    __device__ __forceinline__ void operator()(const Acc& acc, const Unit& u, int wr, int wc, int fr, int fq, LAS const float* rtab) const {
        const int row0 = u.pm * BM + wr * 64 + fr;
        float rsv[8];
#pragma unroll
        for (int i = 0; i < 8; ++i) rsv[i] = rtab[wr * 64 + fr + (i >> 2) * HALF + (i & 3) * 16];
#pragma unroll
        for (int ai = 0; ai < 2; ++ai)
#pragma unroll
            for (int m = 0; m < 4; ++m) {
                const int row = row0 + ai * HALF + m * 16;
                const float rs = rsv[ai * 4 + m];
                float h[8];
#pragma unroll
                for (int n = 0; n < 2; ++n)
#pragma unroll
                    for (int j = 0; j < 4; ++j) { const float gg = acc[ai][0][m][n][j] * rs, uu = acc[ai][1][m][n][j] * rs; h[n * 4 + j] = siluf_(gg) * uu; }
                *(u32x4*)(H + (size_t)row * FF + u.pn * 128 + wc * 32 + 8 * fq) = pack8(h);
            }
    }
};
struct EpiResid {
    static constexpr bool RS_TAB = false;
    bf16* xb; float* fout; float* ssn; float alpha;
    __device__ __forceinline__ void operator()(const Acc& acc, const Unit& u, int wr, int wc, int fr, int fq, LAS const float* rtab) const {
        const int row0 = u.pm * BM + wr * 64 + fr;
        const size_t colb = (size_t)u.pn * BM + wc * 32 + 8 * fq;
#pragma unroll
        for (int ai = 0; ai < 2; ++ai) {
            u32x4 xv[4][2];
#pragma unroll
            for (int m = 0; m < 4; ++m)
#pragma unroll
                for (int bj = 0; bj < 2; ++bj) xv[m][bj] = *(const u32x4*)(xb + (size_t)(row0 + ai * HALF + m * 16) * DM + colb + bj * HALF);
#pragma unroll
            for (int m = 0; m < 4; ++m) {
                const int row = row0 + ai * HALF + m * 16;
                float s = 0.f;
#pragma unroll
                for (int bj = 0; bj < 2; ++bj) {
                    const size_t off = (size_t)row * DM + colb + bj * HALF;
                    float xf[8]; unpack8(xv[m][bj], xf);
                    float v[8];
#pragma unroll
                    for (int j = 0; j < 4; ++j) { v[j] = xf[j] + acc[ai][bj][m][0][j] * alpha; v[4 + j] = xf[4 + j] + acc[ai][bj][m][1][j] * alpha; }
                    if (fout) { *(f32x4*)(fout + off) = (f32x4){v[0], v[1], v[2], v[3]}; *(f32x4*)(fout + off + 4) = (f32x4){v[4], v[5], v[6], v[7]}; }
                    else *(u32x4*)(xb + off) = pack8(v);
#pragma unroll
                    for (int j = 0; j < 8; ++j) s += v[j] * v[j];
                }
                s += __shfl_xor(s, 16); s += __shfl_xor(s, 32);
                if (ssn && fq == 0) ssn[(size_t)row * 16 + u.pn * 4 + wc] = s;
            }
        }
    }
};
struct EpiInProj {
    static constexpr bool RS_TAB = true;
    bf16* P01; bf16* QKV; bf16* Z; const float* ss; float* ssq; float* sskv;
    __device__ __forceinline__ void operator()(const Acc& acc, const Unit& u, int wr, int wc, int fr, int fq, LAS const float* rtab) const {
        bf16* base; int ld, c0;
        if (u.pn < 2) { base = P01; ld = 512; c0 = u.pn * 256; } else if (u.pn < 8) { base = QKV; ld = 1536; c0 = (u.pn - 2) * 256; } else { base = Z; ld = 512; c0 = (u.pn - 8) * 256; }
        const int row0 = u.pm * BM + wr * 64 + fr;
        float rsv[8];
#pragma unroll
        for (int i = 0; i < 8; ++i) rsv[i] = rtab[wr * 64 + fr + (i >> 2) * HALF + (i & 3) * 16];
#pragma unroll
        for (int ai = 0; ai < 2; ++ai)
#pragma unroll
            for (int m = 0; m < 4; ++m) {
                const int row = row0 + ai * HALF + m * 16;
                const float rs = rsv[ai * 4 + m];
                float sq[2];
#pragma unroll
                for (int bj = 0; bj < 2; ++bj) {
                    float v[8]; float s = 0.f;
#pragma unroll
                    for (int n = 0; n < 2; ++n)
#pragma unroll
                        for (int j = 0; j < 4; ++j) { v[n * 4 + j] = acc[ai][bj][m][n][j] * rs; s += v[n * 4 + j] * v[n * 4 + j]; }
                    sq[bj] = s;
                    *(u32x4*)(base + (size_t)row * ld + c0 + bj * HALF + wc * 32 + 8 * fq) = pack8(v);
                }
                if (u.pn < 2) {
                    float s = (u.pn == 0) ? (sq[0] + sq[1]) : sq[0];
                    s += __shfl_xor(s, 16); s += __shfl_xor(s, 32);
                    if (fq == 0) (u.pn == 0 ? ssq : sskv)[(size_t)row * 4 + wc] = s;
                }
            }
    }
};
struct EpiQ {
    static constexpr bool RS_TAB = false;
    bf16* q; const float* ssq;
    __device__ __forceinline__ void operator()(const Acc& acc, const Unit& u, int wr, int wc, int fr, int fq, LAS const float* rtab) const {
        const int row0 = u.pm * BM + wr * 64 + fr;
        float rsv[8]; row_scales<4>(ssq, row0, fq, 1.f / 256.f, rsv);
#pragma unroll
        for (int ai = 0; ai < 2; ++ai)
#pragma unroll
            for (int m = 0; m < 4; ++m) {
                const int row = row0 + ai * HALF + m * 16;
                const float rs = rsv[ai * 4 + m];
#pragma unroll
                for (int bj = 0; bj < 2; ++bj) {
                    float v[8];
#pragma unroll
                    for (int n = 0; n < 2; ++n)
#pragma unroll
                        for (int j = 0; j < 4; ++j) v[n * 4 + j] = acc[ai][bj][m][n][j] * rs;
                    *(u32x4*)(q + (size_t)row * 768 + u.pn * 256 + bj * HALF + wc * 32 + 8 * fq) = pack8(v);
                }
            }
    }
};
struct EpiKV {
    static constexpr bool RS_TAB = false;
    bf16* Kp; bf16* V; const float* sskv;
    __device__ __forceinline__ void operator()(const Acc& acc, const Unit& u, int wr, int wc, int fr, int fq, LAS const float* rtab) const {
        const int row0 = u.pm * BM + wr * 64 + fr;
        float rsv[8]; row_scales<4>(sskv, row0, fq, 1.f / 128.f, rsv);
#pragma unroll
        for (int ai = 0; ai < 2; ++ai)
#pragma unroll
            for (int m = 0; m < 4; ++m) {
                const int row = row0 + ai * HALF + m * 16;
                const float rs = rsv[ai * 4 + m];
#pragma unroll
                for (int bj = 0; bj < 2; ++bj) {
                    float v[8];
#pragma unroll
                    for (int n = 0; n < 2; ++n)
#pragma unroll
                        for (int j = 0; j < 4; ++j) v[n * 4 + j] = acc[ai][bj][m][n][j] * rs;
                    const int head = 2 * u.pn + bj, c = wc * 32 + 8 * fq;
                    bf16* dst = (wc < 2) ? (Kp + (size_t)row * 768 + head * 96 + c) : (V + (size_t)row * 512 + head * 64 + (c - 64));
                    *(u32x4*)dst = pack8(v);
                }
            }
    }
};
struct EpiSgIn {
    static constexpr bool RS_TAB = true;
    bf16* UV; const float* ss; float* ssv;
    __device__ __forceinline__ void operator()(const Acc& acc, const Unit& u, int wr, int wc, int fr, int fq, LAS const float* rtab) const {
        const int row0 = u.pm * BM + wr * 64 + fr;
        float rsv[8];
#pragma unroll
        for (int i = 0; i < 8; ++i) rsv[i] = rtab[wr * 64 + fr + (i >> 2) * HALF + (i & 3) * 16];
#pragma unroll
        for (int ai = 0; ai < 2; ++ai)
#pragma unroll
            for (int m = 0; m < 4; ++m) {
                const int row = row0 + ai * HALF + m * 16;
                const float rs = rsv[ai * 4 + m];
                float s = 0.f;
#pragma unroll
                for (int bj = 0; bj < 2; ++bj) {
                    float v[8];
#pragma unroll
                    for (int n = 0; n < 2; ++n) {
                        const f32x4 a = acc[ai][bj][m][n] * rs;
                        const f32x2 g0 = gelu_pk((f32x2){a[0], a[1]}), g1 = gelu_pk((f32x2){a[2], a[3]});
                        v[n * 4 + 0] = g0.x; v[n * 4 + 1] = g0.y; v[n * 4 + 2] = g1.x; v[n * 4 + 3] = g1.y;
                    }
#pragma unroll
                    for (int j = 0; j < 8; ++j) s += v[j] * v[j];
                    *(u32x4*)(UV + (size_t)row * 4096 + u.pn * 256 + bj * HALF + wc * 32 + 8 * fq) = pack8(v);
                }
                if (u.pn >= 8) {
                    s += __shfl_xor(s, 16); s += __shfl_xor(s, 32);
                    if (fq == 0) ssv[((size_t)row * 8 + (u.pn - 8)) * 4 + wc] = s;
                }
            }
    }
};
}

__device__ __forceinline__ void conv_item(int kind, const float* W0, const float* W1, int ldw, int Kvalid, const float* ks, bf16* dst, int Kdst,
                                          LAS float* scr, int k0, int n0, int lane) {
    const int n = n0 + lane;
    const float* W = W0; int col = n;
    if (kind == 1) { const int tile = n >> 8, r = n & 255; col = (tile << 7) + (r & 127); W = (r < 128) ? W0 : W1; }
    else if (kind == 2) {
        if (n < 416) col = n; else if (n < 424) col = 2464 + (n - 416); else if (n < 432) col = 2472 + (n - 424); else if (n < 512) col = -1;
        else if (n < 2048) col = 416 + (n - 512); else col = 1952 + (n - 2048);
    }
    float cv[64];
#pragma unroll
    for (int i = 0; i < 64; ++i) {
        const int k = k0 + i;
        float v = 0.f;
        if (col >= 0 && k < Kvalid) { v = W[(size_t)k * ldw + col]; if (ks) v *= ks[k]; }
        cv[i] = v;
    }
#pragma unroll
    for (int i = 0; i < 64; ++i) scr[i * 65 + lane] = cv[i];
    LDS_WAIT();
    const int c = lane & 7;
#pragma unroll
    for (int jj = 0; jj < 8; ++jj) {
        const int nn = (lane >> 3) + 8 * jj; const LAS float* s = scr + (8 * c) * 65 + nn;
        u32x4 o; o.x = pk2(s[0 * 65], s[1 * 65]); o.y = pk2(s[2 * 65], s[3 * 65]); o.z = pk2(s[4 * 65], s[5 * 65]); o.w = pk2(s[6 * 65], s[7 * 65]);
        *(u32x4*)(dst + (size_t)(n0 + nn) * Kdst + k0 + 8 * c) = o;
    }
    LDS_WAIT();
}
__device__ __forceinline__ int conv_job(int start, int NGW, int kind, const float* W0, const float* W1, int ldw, int Kvalid, const float* ks, bf16* dst, int Kdst, int Ndst,
                                        LAS float* scr, int lane) {
    const int nkb = Kdst / 64, items = nkb * (Ndst / 64);
    int it = start;
    for (; it < items; it += NGW) { const int kb = it % nkb, nb = it / nkb; conv_item(kind, W0, W1, ldw, Kvalid, ks, dst, Kdst, scr, kb * 64, nb * 64, lane); }
    return it - items;
}
__device__ __forceinline__ void convert_layer(const Params& p, int l, LAS unsigned char* lds) {
    const int tid = otid(), lane = tid & 63, wid = tid >> 6, gw = blockIdx.x * 8 + wid, NGW = gridDim.x * 8;
    LAS float* scr = (LAS float*)(lds + wid * 16640);
    unsigned char* wb = opq(p.ws) + WS_W;
    const float* normw = (const float*)p.in[2] + (size_t)l * 3 * DM;
    const float* wg = (const float*)p.in[3] + (size_t)l * 2 * DM * FF;
    const float* wu = (const float*)p.in[4] + (size_t)l * 2 * DM * FF;
    const float* wd = (const float*)p.in[5] + (size_t)l * 2 * FF * DM;
    int st = gw;
    st = conv_job(st, NGW, 1, wg, wu, FF, DM, normw, (bf16*)(wb + W_1A), DM, 2 * FF, scr, lane);
    st = conv_job(st, NGW, 0, wd, nullptr, DM, FF, nullptr, (bf16*)(wb + W_2A), FF, DM, scr, lane);
    st = conv_job(st, NGW, 1, wg + (size_t)DM * FF, wu + (size_t)DM * FF, FF, DM, normw + 2 * DM, (bf16*)(wb + W_1B), DM, 2 * FF, scr, lane);
    st = conv_job(st, NGW, 0, wd + (size_t)FF * DM, nullptr, DM, FF, nullptr, (bf16*)(wb + W_2B), FF, DM, scr, lane);
    const int e = l >> 1;
    if ((l & 1) == 0) {
        st = conv_job(st, NGW, 2, (const float*)p.in[6] + (size_t)e * DM * 2480, nullptr, 2480, DM, normw + DM, (bf16*)(wb + W_IN), DM, 2560, scr, lane);
        st = conv_job(st, NGW, 0, (const float*)p.in[8] + (size_t)e * 256 * 768, nullptr, 768, 256, (const float*)p.in[7] + e * 256, (bf16*)(wb + W_QB), 256, 768, scr, lane);
        st = conv_job(st, NGW, 0, (const float*)p.in[10] + (size_t)e * 128 * 1024, nullptr, 1024, 128, (const float*)p.in[9] + e * 128, (bf16*)(wb + W_KVB), 256, 1024, scr, lane);
        st = conv_job(st, NGW, 0, (const float*)p.in[17] + (size_t)e * DM * DM, nullptr, DM, DM, nullptr, (bf16*)(wb + W_OUT), DM, DM, scr, lane);
    } else {
        st = conv_job(st, NGW, 0, (const float*)p.in[18] + (size_t)e * DM * 4096, nullptr, 4096, DM, normw + DM, (bf16*)(wb + W_SIN), DM, 4096, scr, lane);
        st = conv_job(st, NGW, 0, (const float*)p.in[22] + (size_t)e * 2048 * DM, nullptr, DM, 2048, nullptr, (bf16*)(wb + W_SOUT), 2048, DM, scr, lane);
        const float* wsrc = (const float*)p.in[20] + (size_t)e * 8 * 128 * 128; bf16* wdst = (bf16*)(wb + W_SS);
        for (int i = gw * 64 + lane; i < 8 * 128 * 128 / 2; i += NGW * 64) {
            const int e0 = 2 * i, jj = e0 & 127, ii = (e0 >> 7) & 127;
            const float a = (jj <= ii) ? wsrc[e0] : 0.f, b = (jj + 1 <= ii) ? wsrc[e0 + 1] : 0.f;
            ((unsigned*)wdst)[i] = pk2(a, b);
        }
    }
}

__device__ __forceinline__ int crow(int r, int hi) { return (r & 3) + 8 * (r >> 2) + 4 * hi; }
__device__ __forceinline__ void attn_unit(LAS unsigned char* lds, const bf16* Q, const bf16* Kp, const bf16* V, bf16* Y, int b, int h, int qb) {
    const int tid = otid(), lane = tid & 63, r32 = lane & 31, hi = lane >> 5; const int wid = __builtin_amdgcn_readfirstlane(tid >> 6);
    constexpr int KPB = 208, VPB = 136, KBUF = 64 * KPB, VBUF = 64 * VPB, KOFF = 0, VOFF = 2 * KBUF;
    const int q0 = qb * 256; const size_t rowbase = (size_t)b * SEQ;
    const bf16* qp = Q + (rowbase + q0 + wid * 32 + r32) * 768 + h * 96 + hi * 8;
    bf16x8 qr[6];
#pragma unroll
    for (int d0 = 0; d0 < 6; ++d0) qr[d0] = *(const bf16x8*)(qp + 16 * d0);
    const int NT = 4 * qb + 4;
    const int kv0 = tid / 12, kc0 = tid % 12, kv1 = (tid + 512) / 12, kc1 = (tid + 512) % 12;
    const bf16* kg = Kp + rowbase * 768 + h * 96;
    const bf16* vg = V + (rowbase + (tid & 63)) * 512 + h * 64 + 8 * (tid >> 6);
    u32x4 kreg0, kreg1 = (u32x4){0, 0, 0, 0}, vreg;
#define A_LOAD(t) do { kreg0 = *(const u32x4*)(kg + (size_t)((t) * 64 + kv0) * 768 + kc0 * 8); if (tid < 256) kreg1 = *(const u32x4*)(kg + (size_t)((t) * 64 + kv1) * 768 + kc1 * 8); \
        vreg = *(const u32x4*)(vg + (size_t)(t) * 64 * 512); } while (0)
#define A_STORE(buf) do { *(LAS u32x4*)(lds + KOFF + (buf) * KBUF + kv0 * KPB + kc0 * 16) = kreg0; if (tid < 256) *(LAS u32x4*)(lds + KOFF + (buf) * KBUF + kv1 * KPB + kc1 * 16) = kreg1; \
        LAS unsigned char* vb_ = lds + VOFF + (buf) * VBUF + (8 * (tid >> 6)) * VPB + 2 * (tid & 63); \
        *(LAS unsigned short*)(vb_ + 0 * VPB) = (unsigned short)(vreg.x & 0xffff); *(LAS unsigned short*)(vb_ + 1 * VPB) = (unsigned short)(vreg.x >> 16); \
        *(LAS unsigned short*)(vb_ + 2 * VPB) = (unsigned short)(vreg.y & 0xffff); *(LAS unsigned short*)(vb_ + 3 * VPB) = (unsigned short)(vreg.y >> 16); \
        *(LAS unsigned short*)(vb_ + 4 * VPB) = (unsigned short)(vreg.z & 0xffff); *(LAS unsigned short*)(vb_ + 5 * VPB) = (unsigned short)(vreg.z >> 16); \
        *(LAS unsigned short*)(vb_ + 6 * VPB) = (unsigned short)(vreg.w & 0xffff); *(LAS unsigned short*)(vb_ + 7 * VPB) = (unsigned short)(vreg.w >> 16); } while (0)
    A_LOAD(0); A_STORE(0);
    __syncthreads();
    float m_run = 0.f, l_run = 0.f;
    f32x16 o[2];
#pragma unroll
    for (int i = 0; i < 16; ++i) { o[0][i] = 0.f; o[1][i] = 0.f; }
    const int qrel = wid * 32 + r32;
    for (int t = 0; t < NT; ++t) {
        const int buf = t & 1;
        if (t + 1 < NT) A_LOAD(t + 1);
        const int jb = t - (NT - 4);
        const bool skip = (jb >= 0) && (64 * jb > wid * 32 + 31);
        if (!skip) {
            f32x16 p0, p1;
            const float nm = -m_run;
#pragma unroll
            for (int i = 0; i < 16; ++i) { p0[i] = nm; p1[i] = nm; }
            LAS const unsigned char* kb = lds + KOFF + buf * KBUF + r32 * KPB + hi * 16;
            LAS const unsigned char* vb = lds + VOFF + buf * VBUF + r32 * VPB + hi * 8;
#pragma unroll
            for (int d0 = 0; d0 < 6; ++d0) p0 = __builtin_amdgcn_mfma_f32_32x32x16_bf16(*(LAS const bf16x8*)(kb + 32 * d0), qr[d0], p0, 0, 0, 0);
#pragma unroll
            for (int d0 = 0; d0 < 6; ++d0) p1 = __builtin_amdgcn_mfma_f32_32x32x16_bf16(*(LAS const bf16x8*)(kb + 32 * KPB + 32 * d0), qr[d0], p1, 0, 0, 0);
#define ATT_HALF(P, KOFS, S0) do { \
            if (jb >= 0) { _Pragma("unroll") for (int r = 0; r < 16; ++r) { const int kv = 64 * jb + (KOFS) + crow(r, hi); if (kv > qrel) P[r] = -INFINITY; } } \
            float mxa = __builtin_fmaxf(__builtin_fmaxf(P[0], P[1]), P[2]), mxb = __builtin_fmaxf(__builtin_fmaxf(P[3], P[4]), P[5]); \
            mxa = __builtin_fmaxf(__builtin_fmaxf(mxa, P[6]), P[7]); mxb = __builtin_fmaxf(__builtin_fmaxf(mxb, P[8]), P[9]); \
            mxa = __builtin_fmaxf(__builtin_fmaxf(mxa, P[10]), P[11]); mxb = __builtin_fmaxf(__builtin_fmaxf(mxb, P[12]), P[13]); \
            mxa = __builtin_fmaxf(__builtin_fmaxf(mxa, P[14]), P[15]); float mx = __builtin_fmaxf(mxa, mxb); \
            { auto rr = __builtin_amdgcn_permlane32_swap(__float_as_uint(mx), __float_as_uint(mx), false, false); mx = fmaxf(__uint_as_float(rr[0]), __uint_as_float(rr[1])); } \
            const float dl = (t == 0 && (KOFS) == 0) ? mx : ((mx > 8.f) ? mx : 0.f);     \
            if (__builtin_amdgcn_ballot_w64(dl != 0.f) != 0ull) { \
                const float alpha = __builtin_amdgcn_exp2f(-dl); \
                m_run += dl; l_run *= alpha; \
                _Pragma("unroll") for (int r = 0; r < 16; ++r) P[r] -= dl; \
                if ((KOFS) == 0) { _Pragma("unroll") for (int r = 0; r < 16; ++r) p1[r] -= dl; } \
                _Pragma("unroll") for (int i = 0; i < 16; ++i) { o[0][i] *= alpha; o[1][i] *= alpha; } \
            } \
            float ls0 = 0.f, ls1 = 0.f; \
            _Pragma("unroll") for (int r = 0; r < 16; r += 2) { P[r] = __builtin_amdgcn_exp2f(P[r]); P[r + 1] = __builtin_amdgcn_exp2f(P[r + 1]); ls0 += P[r]; ls1 += P[r + 1]; } \
            l_run += ls0 + ls1; \
            const u32x4 pwa = (u32x4){pk2(P[0], P[1]), pk2(P[2], P[3]), pk2(P[4], P[5]), pk2(P[6], P[7])}; \
            const u32x4 pwb = (u32x4){pk2(P[8], P[9]), pk2(P[10], P[11]), pk2(P[12], P[13]), pk2(P[14], P[15])}; \
            _Pragma("unroll") for (int d = 0; d < 2; ++d) { \
                const u32x2 lo0 = *(LAS const u32x2*)(vb + d * 32 * VPB + (S0) * 32), hh0 = *(LAS const u32x2*)(vb + d * 32 * VPB + (S0) * 32 + 16); \
                const u32x2 lo1 = *(LAS const u32x2*)(vb + d * 32 * VPB + ((S0) + 1) * 32), hh1 = *(LAS const u32x2*)(vb + d * 32 * VPB + ((S0) + 1) * 32 + 16); \
                o[d] = __builtin_amdgcn_mfma_f32_32x32x16_bf16(__builtin_bit_cast(bf16x8, ((u32x4){lo0.x, lo0.y, hh0.x, hh0.y})), __builtin_bit_cast(bf16x8, pwa), o[d], 0, 0, 0); \
                o[d] = __builtin_amdgcn_mfma_f32_32x32x16_bf16(__builtin_bit_cast(bf16x8, ((u32x4){lo1.x, lo1.y, hh1.x, hh1.y})), __builtin_bit_cast(bf16x8, pwb), o[d], 0, 0, 0); \
            } } while (0)
            ATT_HALF(p0, 0, 0);
            ATT_HALF(p1, 32, 2);
#undef ATT_HALF
        }
        if (t + 1 < NT) A_STORE(buf ^ 1);
        __syncthreads();
    }
#undef A_LOAD
#undef A_STORE
    const float lt = l_run + __shfl_xor(l_run, 32);
    const float inv = 1.f / lt;
    bf16* yp = Y + (rowbase + q0 + wid * 32 + r32) * 1024 + h * 64;
#pragma unroll
    for (int d = 0; d < 2; ++d)
#pragma unroll
        for (int g4 = 0; g4 < 4; ++g4) {
            u32x2 w; w.x = pk2(o[d][4 * g4 + 0] * inv, o[d][4 * g4 + 1] * inv); w.y = pk2(o[d][4 * g4 + 2] * inv, o[d][4 * g4 + 3] * inv);
            *(u32x2*)(yp + 32 * d + 8 * g4 + 4 * hi) = w;
        }
}

__device__ __forceinline__ void gdn_scan(LAS unsigned char* lds, int bh, const bf16* GQ, const bf16* GK, const bf16* U, const bf16* W, const float* GC, const bf16* Z,
                                         const float* onorm, bf16* Y) {
    const int tid = otid(), lane = tid & 63, l15 = lane & 15, l4 = lane >> 4; const int wid = __builtin_amdgcn_readfirstlane(tid >> 6);
    const int b = bh >> 3, h = bh & 7;
    constexpr int PB = 144, QL = 0, KL = 9216, WL = 18432, ST = 27648, VNT = 36864, VNST = 46080, ATT = 55296, KT0 = 64512, OL = 82944, GCL = 100352, OPB = 272;
    const int tb = wid >> 1, db0 = (wid & 1) * 2;
    f32x4 Sacc[2] = {(f32x4){0.f, 0.f, 0.f, 0.f}, (f32x4){0.f, 0.f, 0.f, 0.f}};
    for (int i = tid; i < 9216 / 4; i += 512) *(LAS unsigned*)(lds + ST + i * 4) = 0u;
    const size_t cbase = (size_t)bh * 128;
    const int orow = tid >> 3, oseg = tid & 7;
    u32x4 pq[2], pk_[2], pw_[2], pz[2]; float pgc[2] = {0.f, 0.f}; unsigned short pu[2][2][4];
#define G_LOAD(n, S) do { const size_t tok = (size_t)b * SEQ + (size_t)(n) * 64 + lane; \
        pq[S] = *(const u32x4*)(GQ + tok * 512 + h * 64 + wid * 8); pk_[S] = *(const u32x4*)(GK + tok * 512 + h * 64 + wid * 8); \
        pw_[S] = *(const u32x4*)(W + ((cbase + (n)) * 64 + lane) * 64 + wid * 8); \
        pz[S] = *(const u32x4*)(Z + ((size_t)b * SEQ + (size_t)(n) * 64 + orow) * 512 + h * 64 + oseg * 8); \
        if (tid < 64) pgc[S] = GC[(cbase + (n)) * 64 + tid]; \
        _Pragma("unroll") for (int d = 0; d < 2; ++d) _Pragma("unroll") for (int r = 0; r < 4; ++r) pu[S][d][r] = U[((cbase + (n)) * 64 + 16 * tb + 4 * l4 + r) * 64 + 16 * (db0 + d) + l15]; } while (0)
#define G_STORE(n, S) do { *(LAS u32x4*)(lds + QL + lane * PB + wid * 16) = pq[S]; *(LAS u32x4*)(lds + KL + lane * PB + wid * 16) = pk_[S]; *(LAS u32x4*)(lds + WL + lane * PB + wid * 16) = pw_[S]; \
        LAS unsigned char* kt_ = lds + KT0 + ((n) & 1) * 9216 + (wid * 8) * PB + lane * 2; \
        *(LAS unsigned short*)(kt_ + 0 * PB) = (unsigned short)(pk_[S].x & 0xffff); *(LAS unsigned short*)(kt_ + 1 * PB) = (unsigned short)(pk_[S].x >> 16); \
        *(LAS unsigned short*)(kt_ + 2 * PB) = (unsigned short)(pk_[S].y & 0xffff); *(LAS unsigned short*)(kt_ + 3 * PB) = (unsigned short)(pk_[S].y >> 16); \
        *(LAS unsigned short*)(kt_ + 4 * PB) = (unsigned short)(pk_[S].z & 0xffff); *(LAS unsigned short*)(kt_ + 5 * PB) = (unsigned short)(pk_[S].z >> 16); \
        *(LAS unsigned short*)(kt_ + 6 * PB) = (unsigned short)(pk_[S].w & 0xffff); *(LAS unsigned short*)(kt_ + 7 * PB) = (unsigned short)(pk_[S].w >> 16); \
        if (tid < 64) *(LAS float*)(lds + GCL + tid * 4) = pgc[S]; \
        _Pragma("unroll") for (int d = 0; d < 2; ++d) _Pragma("unroll") for (int r = 0; r < 4; ++r) uc[d][r] = bf2f(pu[S][d][r]); \
        z_norm = z_pend; z_pend = pz[S]; } while (0)
    float uc[2][4];
    u32x4 z_norm = (u32x4){0u, 0u, 0u, 0u}, z_pend = z_norm;
    G_LOAD(0, 0);
    G_STORE(0, 0);
    G_LOAD(1, 1);
    __syncthreads();
    float onw[8];
#pragma unroll
    for (int e = 0; e < 8; ++e) onw[e] = onorm[oseg * 8 + e];
#define SCAN_COMPUTE(NN) do { \
        f32x4 pacc[2], qs[2], at[2]; \
_Pragma("unroll") \
        for (int d = 0; d < 2; ++d) { pacc[d] = (f32x4){0.f, 0.f, 0.f, 0.f}; qs[d] = pacc[d]; at[d] = pacc[d]; } \
_Pragma("unroll") \
        for (int ks = 0; ks < 2; ++ks) { \
            const bf16x8 aw = lds8(lds + WL, 16 * tb + l15, PB, 32 * ks + 8 * l4), aq = lds8(lds + QL, 16 * tb + l15, PB, 32 * ks + 8 * l4); \
_Pragma("unroll") \
            for (int d = 0; d < 2; ++d) { \
                const bf16x8 bs = lds8(lds + ST, 16 * (db0 + d) + l15, PB, 32 * ks + 8 * l4), bk = lds8(lds + KL, 16 * (db0 + d) + l15, PB, 32 * ks + 8 * l4); \
                pacc[d] = mfma16(aw, bs, pacc[d]); qs[d] = mfma16(aq, bs, qs[d]); at[d] = mfma16(aq, bk, at[d]); \
            } \
        } \
        float gci[4]; \
_Pragma("unroll") \
        for (int r = 0; r < 4; ++r) gci[r] = *(LAS const float*)(lds + GCL + (16 * tb + 4 * l4 + r) * 4); \
        const float glast = *(LAS const float*)(lds + GCL + 63 * 4); \
        const float eg = __expf(glast); \
_Pragma("unroll") \
        for (int d = 0; d < 2; ++d) { \
            float vn[4], vs[4]; \
_Pragma("unroll") \
            for (int r = 0; r < 4; ++r) { vn[r] = uc[d][r] - pacc[d][r]; vs[r] = vn[r] * __expf(glast - gci[r]); } \
            const int dvrow = 16 * (db0 + d) + l15; \
            *(LAS u32x2*)(lds + VNT + dvrow * PB + (16 * tb + 4 * l4) * 2) = (u32x2){pk2(vn[0], vn[1]), pk2(vn[2], vn[3])}; \
            *(LAS u32x2*)(lds + VNST + dvrow * PB + (16 * tb + 4 * l4) * 2) = (u32x2){pk2(vs[0], vs[1]), pk2(vs[2], vs[3])}; \
            const int j = 16 * (db0 + d) + l15; const float gcj = *(LAS const float*)(lds + GCL + j * 4); \
_Pragma("unroll") \
            for (int r = 0; r < 4; ++r) { \
                const int i = 16 * tb + 4 * l4 + r; \
                const float val = (j <= i) ? at[d][r] * __expf(gci[r] - gcj) : 0.f; \
                *(LAS unsigned short*)(lds + ATT + i * PB + j * 2) = (unsigned short)(pk2(val, 0.f) & 0xffff); \
                qs[d][r] *= __expf(gci[r]); \
            } \
        } \
        if ((NN) > 0) { \
            const f32x4 o0 = *(LAS const f32x4*)(lds + OL + orow * OPB + oseg * 32), o1 = *(LAS const f32x4*)(lds + OL + orow * OPB + oseg * 32 + 16); \
            float ss = (o0[0] * o0[0] + o0[1] * o0[1]) + (o0[2] * o0[2] + o0[3] * o0[3]) + (o1[0] * o1[0] + o1[1] * o1[1]) + (o1[2] * o1[2] + o1[3] * o1[3]); \
            ss += __shfl_xor(ss, 1); ss += __shfl_xor(ss, 2); ss += __shfl_xor(ss, 4); \
            const float rs = rsqrtf(ss * (1.f / 64.f) + EPS); \
            const size_t tok = (size_t)b * SEQ + (size_t)((NN) - 1) * 64 + orow; \
            const u32x4 zr = z_norm; \
            float zf[8], of[8] = {o0[0], o0[1], o0[2], o0[3], o1[0], o1[1], o1[2], o1[3]}; \
            unpack8(zr, zf); \
_Pragma("unroll") \
            for (int e = 0; e < 8; ++e) of[e] = of[e] * rs * onw[e] * siluf_(zf[e]); \
            *(u32x4*)(Y + tok * 1024 + 512 + h * 64 + oseg * 8) = pack8(of); \
        } \
        __syncthreads(); \
_Pragma("unroll") \
        for (int ks = 0; ks < 2; ++ks) { \
            const bf16x8 aa = lds8(lds + ATT, 16 * tb + l15, PB, 32 * ks + 8 * l4), ak = lds8(lds + KT0 + ((NN) & 1) * 9216, 16 * tb + l15, PB, 32 * ks + 8 * l4); \
_Pragma("unroll") \
            for (int d = 0; d < 2; ++d) { \
                const bf16x8 bv = lds8(lds + VNT, 16 * (db0 + d) + l15, PB, 32 * ks + 8 * l4), bvs = lds8(lds + VNST, 16 * (db0 + d) + l15, PB, 32 * ks + 8 * l4); \
                qs[d] = mfma16(aa, bv, qs[d]); \
                if (ks == 0) Sacc[d] = Sacc[d] * eg; \
                Sacc[d] = mfma16(ak, bvs, Sacc[d]); \
            } \
        } \
_Pragma("unroll") \
        for (int d = 0; d < 2; ++d) { \
_Pragma("unroll") \
            for (int r = 0; r < 4; ++r) *(LAS float*)(lds + OL + (16 * tb + 4 * l4 + r) * OPB + (16 * (db0 + d) + l15) * 4) = qs[d][r]; \
            *(LAS u32x2*)(lds + ST + (16 * (db0 + d) + l15) * PB + (16 * tb + 4 * l4) * 2) = (u32x2){pk2(Sacc[d][0], Sacc[d][1]), pk2(Sacc[d][2], Sacc[d][3])}; \
        } \
    } while (0)
#define SCAN_STEP(NN, SL, SS) do { \
        if ((NN) + 2 < 128) G_LOAD((NN) + 2, SL); \
        SCAN_COMPUTE(NN); \
        if ((NN) + 1 < 128) G_STORE((NN) + 1, SS); else { z_norm = z_pend; } \
        __syncthreads(); } while (0)
    for (int n = 0; n < 128; n += 2) {
        SCAN_STEP(n, 0, 1);
        SCAN_STEP(n + 1, 1, 0);
    }
#undef SCAN_STEP
#undef SCAN_COMPUTE
#undef G_LOAD
#undef G_STORE
    {
        const f32x4 o0 = *(LAS const f32x4*)(lds + OL + orow * OPB + oseg * 32), o1 = *(LAS const f32x4*)(lds + OL + orow * OPB + oseg * 32 + 16);
        float ss = (o0[0] * o0[0] + o0[1] * o0[1]) + (o0[2] * o0[2] + o0[3] * o0[3]) + (o1[0] * o1[0] + o1[1] * o1[1]) + (o1[2] * o1[2] + o1[3] * o1[3]);
        ss += __shfl_xor(ss, 1); ss += __shfl_xor(ss, 2); ss += __shfl_xor(ss, 4);
        const float rs = rsqrtf(ss * (1.f / 64.f) + EPS);
        const size_t tok = (size_t)b * SEQ + (size_t)127 * 64 + orow;
        const u32x4 zr = z_norm;
        float zf[8], of[8] = {o0[0], o0[1], o0[2], o0[3], o1[0], o1[1], o1[2], o1[3]};
        unpack8(zr, zf);
#pragma unroll
        for (int e = 0; e < 8; ++e) of[e] = of[e] * rs * onw[e] * siluf_(zf[e]);
        *(u32x4*)(Y + tok * 1024 + 512 + h * 64 + oseg * 8) = pack8(of);
    }
    __syncthreads();
}

__device__ __forceinline__ void gdn_pre(const Params& p, int e) {
    const int tid = otid(), lane = tid & 63, gw = blockIdx.x * 8 + (tid >> 6), NGW = gridDim.x * 8;
    unsigned char* ws = opq(p.ws);
    const bf16* QKV = (const bf16*)(ws + A_QKV); const bf16* P01 = (const bf16*)(ws + A_P01);
    bf16* GQ = (bf16*)(ws + A_GQ); bf16* GK = (bf16*)(ws + A_GK); bf16* GV = (bf16*)(ws + A_GV);
    const float* cw = (const float*)p.in[13] + (size_t)e * 4 * 1536;
    const float* alog = (const float*)p.in[14] + e * 8; const float* dtb = (const float*)p.in[15] + e * 8;
    for (int blk = gw; blk < T / 16; blk += NGW) {
        const int t0 = blk * 16, s0 = t0 & (SEQ - 1);
#pragma unroll 1
        for (int part = 0; part < 3; ++part) {
            const int c0 = part * 512 + lane * 8;
            u32x4 xr[19];
#pragma unroll
            for (int i = 0; i < 19; ++i) xr[i] = (s0 + i - 3 >= 0) ? *(const u32x4*)(QKV + (size_t)(t0 + i - 3) * 1536 + c0) : (u32x4){0u, 0u, 0u, 0u};
            float w[4][8];
#pragma unroll
            for (int j = 0; j < 4; ++j) { const f32x4 w0 = *(const f32x4*)(cw + j * 1536 + c0), w1 = *(const f32x4*)(cw + j * 1536 + c0 + 4);
                w[j][0] = w0[0]; w[j][1] = w0[1]; w[j][2] = w0[2]; w[j][3] = w0[3]; w[j][4] = w1[0]; w[j][5] = w1[1]; w[j][6] = w1[2]; w[j][7] = w1[3]; }
            bf16* dstb = (part == 0 ? GQ : (part == 1 ? GK : GV)) + (size_t)t0 * 512 + lane * 8;
#pragma unroll
            for (int i = 0; i < 16; ++i) {
                float acc[8];
#pragma unroll
                for (int k = 0; k < 8; ++k) acc[k] = 0.f;
#pragma unroll
                for (int j = 0; j < 4; ++j) { float xf[8]; unpack8(xr[i + j], xf);
#pragma unroll
                    for (int k = 0; k < 8; ++k) acc[k] += xf[k] * w[j][k]; }
                float ss = 0.f;
#pragma unroll
                for (int k = 0; k < 8; ++k) { acc[k] = siluf_(acc[k]); ss += acc[k] * acc[k]; }
                if (part < 2) {
                    ss += __shfl_xor(ss, 1); ss += __shfl_xor(ss, 2); ss += __shfl_xor(ss, 4);
                    const float sc = rsqrtf(ss + EPS) * (part == 0 ? 0.125f : 1.f);
#pragma unroll
                    for (int k = 0; k < 8; ++k) acc[k] *= sc;
                }
                *(u32x4*)(dstb + (size_t)i * 512) = pack8(acc);
            }
        }
#pragma unroll
        for (int k2 = 0; k2 < 2; ++k2) {
            const int idx = lane + 64 * k2, tk = idx >> 3, hh = idx & 7; const size_t t = (size_t)t0 + tk;
            const float bl = bf2f(P01[t * 512 + 416 + hh]);
            ((float*)(ws + A_BETA))[t * 8 + hh] = sigmoidf_(bl);
            const float x = bf2f(P01[t * 512 + 424 + hh]) + dtb[hh];
            const float ex = __expf(x); const float sp = (x > 20.f) ? x : (ex < 0.01f ? ex * (1.f - ex * (0.5f - ex * (1.f / 3.f))) : __logf(1.f + ex));
            ((float*)(ws + A_GG))[t * 8 + hh] = -__expf(alog[hh]) * sp;
        }
    }
}

__device__ __forceinline__ void gdn_prep(const Params& p, LAS unsigned char* lds) {
    const int tid = otid(), lane = tid & 63, l15 = lane & 15, l4 = lane >> 4, sg = tid >> 7, st = tid & 127, w2 = (tid >> 6) & 1;
    unsigned char* ws = opq(p.ws);
    const bf16* GK = (const bf16*)(ws + A_GK); const bf16* GV = (const bf16*)(ws + A_GV);
    bf16* U = (bf16*)(ws + A_U); bf16* W = (bf16*)(ws + A_WW);
    float* ctl = (float*)(ws + WS_CTL);
    LAS unsigned char* L = lds + sg * 36864;
    constexpr int PB = 144, KL2 = 0, VL = 9216, AF = 18432, GCX = 35840, BEX = 36096, EWX = 36352;
    for (int base = blockIdx.x * 4; base < 4096; base += gridDim.x * 4) {
        const int task = base + sg, bh = task >> 7, n = task & 127, b = bh >> 3, h = bh & 7;
        const size_t tok0 = (size_t)b * SEQ + (size_t)n * 64;
#pragma unroll
        for (int i = 0; i < 4; ++i) { const int idx = st + 128 * i, row = idx >> 3, ch = idx & 7;
            *(LAS u32x4*)(L + KL2 + row * PB + ch * 16) = *(const u32x4*)(GK + (tok0 + row) * 512 + h * 64 + ch * 8);
            *(LAS u32x4*)(L + VL + row * PB + ch * 16) = *(const u32x4*)(GV + (tok0 + row) * 512 + h * 64 + ch * 8); }
        if (st < 64) {
            const float be = ((const float*)(ws + A_BETA))[(tok0 + st) * 8 + h]; float gg = ((const float*)(ws + A_GG))[(tok0 + st) * 8 + h];
#pragma unroll
            for (int off = 1; off < 64; off <<= 1) { const float tt = __shfl_up(gg, off); if (lane >= off) gg += tt; }
            *(LAS float*)(L + GCX + st * 4) = gg; *(LAS float*)(L + BEX + st * 4) = be; *(LAS float*)(L + EWX + st * 4) = be * __expf(gg);
            ((float*)(ws + A_GC))[((size_t)bh * 128 + n) * 64 + st] = gg;
        }
        __syncthreads();
#pragma unroll 1
        for (int k = 0; k < 8; ++k) {
            const int t16 = w2 * 8 + k, ti = t16 >> 2, tj = t16 & 3;
            f32x4 acc = (f32x4){0.f, 0.f, 0.f, 0.f};
            if (tj <= ti) {
#pragma unroll
                for (int ks = 0; ks < 2; ++ks) acc = mfma16(lds8(L + KL2, 16 * ti + l15, PB, 32 * ks + 8 * l4), lds8(L + KL2, 16 * tj + l15, PB, 32 * ks + 8 * l4), acc);
            }
            const int j = 16 * tj + l15; const float gcj = *(LAS const float*)(L + GCX + j * 4);
#pragma unroll
            for (int r = 0; r < 4; ++r) {
                const int i = 16 * ti + 4 * l4 + r;
                const float gi = *(LAS const float*)(L + GCX + i * 4), bi = *(LAS const float*)(L + BEX + i * 4);
                const float val = (j < i) ? bi * acc[r] * __expf(gi - gcj) : 0.f;
                *(LAS float*)(L + AF + (i * 68 + j) * 4) = val;
            }
        }
        __syncthreads();
        {
            const int c = st & 63; const bool isw = st >= 64;
            LAS const unsigned char* rb = L + (isw ? KL2 : VL) + c * 2;
            LAS const unsigned char* sb = L + (isw ? EWX : BEX);
            float x[64];
#pragma unroll
            for (int i = 0; i < 64; ++i) {
                float a0 = bf2f(*(LAS const unsigned short*)(rb + i * PB)) * *(LAS const float*)(sb + i * 4), a1 = 0.f;
#pragma unroll
                for (int j4 = 0; j4 < (i + 3) / 4; ++j4) {
                    const f32x4 av = *(LAS const f32x4*)(L + AF + (i * 68 + j4 * 4) * 4);
#pragma unroll
                    for (int jj = 0; jj < 4; ++jj) if (j4 * 4 + jj < i) { if (jj & 1) a1 -= av[jj] * x[j4 * 4 + jj]; else a0 -= av[jj] * x[j4 * 4 + jj]; }
                }
                x[i] = a0 + a1;
                asm volatile("" ::: "memory");
            }
            bf16* dst = (isw ? W : U) + ((size_t)bh * 128 + n) * 4096 + c;
#pragma unroll
            for (int i = 0; i < 64; ++i) dst[i * 64] = (unsigned short)(pk2(x[i], 0.f) & 0xffff);
        }
        __syncthreads();
    }
}

__device__ __forceinline__ void qk_prep(const Params& p, int e) {
    const int tid = otid(), lane = tid & 63, gw = blockIdx.x * 8 + (tid >> 6), NGW = gridDim.x * 8;
    unsigned char* ws = opq(p.ws);
    bf16* Q = (bf16*)(ws + A_Q); bf16* Kp = (bf16*)(ws + A_KP); const bf16* P01 = (const bf16*)(ws + A_P01);
    const int* pos = (const int*)p.in[1];
    const float* wq = (const float*)p.in[11] + e * 96; const float* wk = (const float*)p.in[12] + e * 96;
    const int sub = lane & 7, hh = lane >> 3;
    const float C2 = 0.10206207261596577f * 1.4426950408889634f;
    float wqn[8], wkn[8], wqr[4], wkr[4];
#pragma unroll
    for (int k = 0; k < 8; ++k) { wqn[k] = wq[8 * sub + k]; wkn[k] = wk[8 * sub + k]; }
    wqr[0] = wq[64 + 2 * sub]; wqr[1] = wq[65 + 2 * sub]; wqr[2] = wq[80 + 2 * sub]; wqr[3] = wq[81 + 2 * sub];
    wkr[0] = wk[64 + 2 * sub]; wkr[1] = wk[65 + 2 * sub]; wkr[2] = wk[80 + 2 * sub]; wkr[3] = wk[81 + 2 * sub];
    float invf[2];
#pragma unroll
    for (int ii = 0; ii < 2; ++ii) invf[ii] = exp2f(-(float)(2 * sub + ii) * (13.287712379549449f / 16.f));
    constexpr int NT4 = 4;
    for (int tb = gw; tb < T; tb += NGW * NT4) {
        int ps[NT4]; u32x4 qn[NT4], kn[NT4]; unsigned q1[NT4], q2[NT4], k1[NT4], k2[NT4];
#pragma unroll
        for (int k = 0; k < NT4; ++k) {
            const int t = tb + k * NGW;
            ps[k] = pos[t];
            const bf16* qp = Q + (size_t)t * 768 + hh * 96; const bf16* kp = Kp + (size_t)t * 768 + hh * 96;
            qn[k] = *(const u32x4*)(qp + 8 * sub); q1[k] = *(const unsigned*)(qp + 64 + 2 * sub); q2[k] = *(const unsigned*)(qp + 80 + 2 * sub);
            kn[k] = *(const u32x4*)(kp + 8 * sub);
            k1[k] = *(const unsigned*)(P01 + (size_t)t * 512 + 384 + 2 * sub); k2[k] = *(const unsigned*)(P01 + (size_t)t * 512 + 400 + 2 * sub);
        }
#pragma unroll
        for (int k = 0; k < NT4; ++k) {
            const int t = tb + k * NGW;
            const float fp = (float)ps[k];
            float cs[2], sn[2];
#pragma unroll
            for (int ii = 0; ii < 2; ++ii) {
                const float a = fp * invf[ii];
                const float rev = a * 0.15915494309189535f;
                const float err = __builtin_fmaf(a, 0.15915494309189535f, -rev);
                const float fr = (rev - rintf(rev)) + err;
                sn[ii] = __builtin_amdgcn_sinf(fr); cs[ii] = __builtin_amdgcn_cosf(fr);
            }
            {
                bf16* qp = Q + (size_t)t * 768 + hh * 96;
                float f[8]; unpack8(qn[k], f);
                float a1[2] = {bflo(q1[k]), bfhi(q1[k])}, a2[2] = {bflo(q2[k]), bfhi(q2[k])};
                float ss = a1[0] * a1[0] + a1[1] * a1[1] + a2[0] * a2[0] + a2[1] * a2[1];
#pragma unroll
                for (int c = 0; c < 8; ++c) ss += f[c] * f[c];
                ss += __shfl_xor(ss, 1); ss += __shfl_xor(ss, 2); ss += __shfl_xor(ss, 4);
                const float rs = rsqrtf(ss * (1.f / 96.f) + EPS) * C2;
#pragma unroll
                for (int c = 0; c < 8; ++c) f[c] *= rs * wqn[c];
                const float n1a = a1[0] * rs * wqr[0], n1b = a1[1] * rs * wqr[1], n2a = a2[0] * rs * wqr[2], n2b = a2[1] * rs * wqr[3];
                *(u32x4*)(qp + 8 * sub) = pack8(f);
                *(unsigned*)(qp + 64 + 2 * sub) = pk2(n1a * cs[0] - n2a * sn[0], n1b * cs[1] - n2b * sn[1]);
                *(unsigned*)(qp + 80 + 2 * sub) = pk2(n2a * cs[0] + n1a * sn[0], n2b * cs[1] + n1b * sn[1]);
            }
            {
                bf16* kp = Kp + (size_t)t * 768 + hh * 96;
                float f[8]; unpack8(kn[k], f);
                float a1[2] = {bflo(k1[k]), bfhi(k1[k])}, a2[2] = {bflo(k2[k]), bfhi(k2[k])};
                float ss = a1[0] * a1[0] + a1[1] * a1[1] + a2[0] * a2[0] + a2[1] * a2[1];
#pragma unroll
                for (int c = 0; c < 8; ++c) ss += f[c] * f[c];
                ss += __shfl_xor(ss, 1); ss += __shfl_xor(ss, 2); ss += __shfl_xor(ss, 4);
                const float rs = rsqrtf(ss * (1.f / 96.f) + EPS);
#pragma unroll
                for (int c = 0; c < 8; ++c) f[c] *= rs * wkn[c];
                const float n1a = a1[0] * rs * wkr[0], n1b = a1[1] * rs * wkr[1], n2a = a2[0] * rs * wkr[2], n2b = a2[1] * rs * wkr[3];
                *(u32x4*)(kp + 8 * sub) = pack8(f);
                *(unsigned*)(kp + 64 + 2 * sub) = pk2(n1a * cs[0] - n2a * sn[0], n1b * cs[1] - n2b * sn[1]);
                *(unsigned*)(kp + 80 + 2 * sub) = pk2(n2a * cs[0] + n1a * sn[0], n2b * cs[1] + n1b * sn[1]);
            }
        }
    }
}

__device__ __forceinline__ void sg_phase(const Params& p, int o, LAS unsigned char* lds) {
    const int tid = otid(), lane = tid & 63, l15 = lane & 15, l4 = lane >> 4; const int wid = __builtin_amdgcn_readfirstlane(tid >> 6);
    unsigned char* ws = opq(p.ws);
    const bf16* UV = (const bf16*)(ws + A_UV); bf16* UG = (bf16*)(ws + A_UG);
    const bf16* Wsb = (const bf16*)(ws + WS_W + W_SS);
    const float* ssv = (const float*)(ws + A_SSV);
    const float* vnorm = (const float*)p.in[19] + (size_t)o * 2048;
    const float* bs = (const float*)p.in[21] + (size_t)o * 8 * 128;
    constexpr int VP = 272;
    u32x4 vr[8]; f32x4 sv[8];
#define SG_LOAD(task_) do { const int g_ = (task_) & 7; const size_t tk0_ = (size_t)((task_) >> 3) * 128; \
        _Pragma("unroll") for (int i = 0; i < 8; ++i) { const int idx = tid + 512 * i, j = idx & 127, cc = idx >> 7; \
            vr[i] = *(const u32x4*)(UV + (tk0_ + j) * 4096 + 2048 + g_ * 256 + cc * 8); sv[i] = *(const f32x4*)(ssv + ((tk0_ + j) * 8 + g_) * 4); } } while (0)
    if ((int)blockIdx.x < 2048) SG_LOAD(blockIdx.x);
    for (int task = blockIdx.x; task < 2048; task += gridDim.x) {
        const int g = task & 7, chunk = task >> 3; const size_t tok0 = (size_t)chunk * 128;
#pragma unroll
        for (int i = 0; i < 8; ++i) {
            const int idx = tid + 512 * i, j = idx & 127, cc = idx >> 7;
            const float rs = rsqrtf(((sv[i][0] + sv[i][1]) + (sv[i][2] + sv[i][3])) * (1.f / 256.f) + EPS);
            float f[8]; unpack8(vr[i], f);
            const f32x4 n0 = *(const f32x4*)(vnorm + g * 256 + cc * 8), n1 = *(const f32x4*)(vnorm + g * 256 + cc * 8 + 4);
            const float nf[8] = {n0[0], n0[1], n0[2], n0[3], n1[0], n1[1], n1[2], n1[3]};
            LAS unsigned char* d = lds + (cc * 8) * VP + j * 2;
#pragma unroll
            for (int k = 0; k < 8; ++k) *(LAS unsigned short*)(d + k * VP) = (unsigned short)(pk2(f[k] * rs * nf[k], 0.f) & 0xffff);
        }
        if (task + (int)gridDim.x < 2048) SG_LOAD(task + gridDim.x);
        __syncthreads();
        const int nks = (wid >> 1) + 1;
        bf16x8 wf[4];
#pragma unroll
        for (int ks = 0; ks < 4; ++ks) wf[ks] = (ks < nks) ? *(const bf16x8*)(Wsb + ((size_t)(g * 128 + 16 * wid + l15)) * 128 + 32 * ks + 8 * l4) : (bf16x8){0, 0, 0, 0, 0, 0, 0, 0};
        const int irow = 16 * wid + l15;
        const float bsi = bs[g * 128 + irow];
#pragma unroll 4
        for (int ct = 0; ct < 16; ++ct) {
            f32x4 acc = (f32x4){0.f, 0.f, 0.f, 0.f};
#pragma unroll
            for (int ks = 0; ks < 4; ++ks) if (ks < nks) acc = mfma16(lds8(lds, 16 * ct + l15, VP, 32 * ks + 8 * l4), wf[ks], acc);
            *(LAS u32x2*)(lds + 69632 + irow * 528 + (16 * ct + 4 * l4) * 2) = (u32x2){pk2(acc[0] + bsi, acc[1] + bsi), pk2(acc[2] + bsi, acc[3] + bsi)};
        }
        __syncthreads();
#pragma unroll
        for (int k = 0; k < 8; ++k) {
            const int idx = tid + 512 * k, row = idx >> 5, ch = idx & 31;
            const u32x4 gr = *(LAS const u32x4*)(lds + 69632 + row * 528 + ch * 16);
            const u32x4 ur = *(const u32x4*)(UV + (tok0 + row) * 4096 + g * 256 + ch * 8);
            float gf[8], uf[8]; unpack8(gr, gf); unpack8(ur, uf);
#pragma unroll
            for (int c = 0; c < 8; ++c) uf[c] *= gf[c];
            *(u32x4*)(UG + (tok0 + row) * 2048 + g * 256 + ch * 8) = pack8(uf);
        }
    }
#undef SG_LOAD
}

#define XB_TMO      128
#define XB_XCNT(j)  (256  + 64 * (j))
#define XB_XSUB(j)  (1280 + 64 * (j))
#define XB_XGEN(j)  (2304 + 64 * (j))
#define XB_TOP      3328
#define XB_TOPGEN   3392
#define XCD_BAR_WORDS 3456
#define XB_SPIN_CAP (1u << 18)
__device__ __forceinline__ unsigned xb_ld(unsigned* p)              { return __hip_atomic_load(p, __ATOMIC_RELAXED, __HIP_MEMORY_SCOPE_AGENT); }
__device__ __forceinline__ unsigned xb_add(unsigned* p, unsigned v) { return __hip_atomic_fetch_add(p, v, __ATOMIC_RELAXED, __HIP_MEMORY_SCOPE_AGENT); }
__device__ __forceinline__ unsigned xb_xcc_id() { return (unsigned)__builtin_amdgcn_s_getreg((3 << 11) | 20) & 0xFu; }
#define XB_SPIN(cond, bar) do { unsigned _sp = 0; while (cond) { __builtin_amdgcn_s_sleep(1); \
    if ((++_sp & 255u) == 0u) { if (xb_ld(&(bar)[XB_TMO])) break; if (_sp > XB_SPIN_CAP) { atomicAdd(&(bar)[XB_TMO], 1u); break; } } } } while (0)
struct XcdBarrier { unsigned* bar; unsigned x; volatile LAS unsigned* st; };
__device__ __forceinline__ XcdBarrier xcd_barrier_post(unsigned* bar, volatile LAS unsigned* st) {
    XcdBarrier b; b.bar = bar; b.x = xb_xcc_id(); b.st = st;
    if (threadIdx.x == 0) (void)xb_add(&bar[XB_XCNT(b.x)], 1u);
    return b;
}
__device__ __forceinline__ void xcd_barrier_complete(unsigned* bar, unsigned x, unsigned& nloc, unsigned& nx) {
    const unsigned G = gridDim.x * gridDim.y * gridDim.z;
    unsigned sum, cnt, mine, sp = 0u;
    for (;;) {
        sum = 0u; cnt = 0u; mine = 0u;
#pragma unroll
        for (unsigned j = 0; j < 16; ++j) { const unsigned c = xb_ld(&bar[XB_XCNT(j)]); sum += c; cnt += (c > 0u) ? 1u : 0u; mine = (j == x) ? c : mine; }
        if (sum == G) break;
        __builtin_amdgcn_s_sleep(1);
        if ((++sp & 255u) == 0u) { if (xb_ld(&bar[XB_TMO])) break; if (sp > XB_SPIN_CAP) { atomicAdd(&bar[XB_TMO], 1u); break; } }
    }
    nloc = mine > 0u ? mine : 1u; nx = cnt > 0u ? cnt : 1u;
}
__device__ __forceinline__ void xcd_barrier(const XcdBarrier& b) {
    asm volatile("s_waitcnt vmcnt(0)" ::: "memory");
    __syncthreads();
    if (threadIdx.x == 0) {
        unsigned* bar = b.bar;
        __builtin_amdgcn_s_waitcnt(0);
        unsigned nloc = b.st[0], nx = b.st[1];
        if (nloc == 0u) { xcd_barrier_complete(bar, b.x, nloc, nx); b.st[0] = nloc; b.st[1] = nx; }
        const unsigned old = xb_add(&bar[XB_XSUB(b.x)], 1u);
        const unsigned gen = old / nloc;
        if (old + 1u == (gen + 1u) * nloc) {
            __builtin_amdgcn_fence(__ATOMIC_RELEASE, "agent");
            asm volatile("s_waitcnt vmcnt(0)" ::: "memory");
            const unsigned og = xb_add(&bar[XB_TOP], 1u);
            const unsigned tg = og / nx;
            if (og + 1u == (tg + 1u) * nx) xb_add(&bar[XB_TOPGEN], 1u);
            else XB_SPIN(xb_ld(&bar[XB_TOPGEN]) == tg, bar);
            __builtin_amdgcn_fence(__ATOMIC_ACQUIRE, "agent");
            xb_add(&bar[XB_XGEN(b.x)], 1u);
            asm volatile("s_waitcnt vmcnt(0)" ::: "memory");
        } else {
            XB_SPIN(xb_ld(&bar[XB_XGEN(b.x)]) == gen, bar);
            __builtin_amdgcn_fence(__ATOMIC_ACQUIRE, "agent");
            asm volatile("s_waitcnt vmcnt(0)" ::: "memory");
        }
    }
    __syncthreads();
}

__global__ void __launch_bounds__(512, 2) mega_fwd(Params p) {
    extern __shared__ __attribute__((aligned(16))) unsigned char shm[];
    LAS unsigned char* lds = (LAS unsigned char*)shm;
    cg::grid_group grid = cg::this_grid();
    const int G = gridDim.x;
    {
        const int t0 = threadIdx.x;
        if (t0 < 16) ((LAS unsigned*)(lds + LDS_BYTES - 64))[t0] = 0u;
        __syncthreads();
    }
    XcdBarrier xbar = xcd_barrier_post((unsigned*)((float*)(p.ws + WS_CTL) + C_BAR), (volatile LAS unsigned*)(lds + LDS_BYTES - 32));
#define GRID_SYNC() do { xcd_barrier(xbar); if (PROBE_SYNC) xcd_barrier(xbar); } while (0)
#define PH_PTRS unsigned char* ws = opq(p.ws); float* ctl = (float*)(ws + WS_CTL); bf16* xb = (bf16*)(ws + WS_XB); unsigned char* wb = ws + WS_W; (void)ctl; (void)xb; (void)wb;

    {
        PH_PTRS
        const int tid = otid(), lane = tid & 63, wid = tid >> 6, gw = blockIdx.x * 8 + wid, NGW = G * 8;
        const float* x = (const float*)p.in[0];
        for (int mb = gw; mb < T; mb += NGW * 4) {
            f32x4 v[4][4];
#pragma unroll
            for (int k = 0; k < 4; ++k) { const f32x4* xr = (const f32x4*)(x + (size_t)(mb + k * NGW) * DM) + lane;
#pragma unroll
                for (int j = 0; j < 4; ++j) v[k][j] = xr[64 * j]; }
#pragma unroll
            for (int k = 0; k < 4; ++k) {
                const int m = mb + k * NGW; float s = 0.f;
#pragma unroll
                for (int j = 0; j < 4; ++j) s += (v[k][j][0] * v[k][j][0] + v[k][j][1] * v[k][j][1]) + (v[k][j][2] * v[k][j][2] + v[k][j][3] * v[k][j][3]);
                s = wave_sum(s);
                if (lane < 16) ctl[C_SSX + (size_t)m * 16 + lane] = (lane == 0) ? s : 0.f;
                u32x2* o8 = (u32x2*)(xb + (size_t)m * DM) + lane;
#pragma unroll
                for (int j = 0; j < 4; ++j) o8[64 * j] = (u32x2){pk2(v[k][j][0], v[k][j][1]), pk2(v[k][j][2], v[k][j][3])};
            }
        }
        convert_layer(p, 0, lds);
    }
    if (p.ws == nullptr) grid.sync();
    GRID_SYNC();

    for (int l = 0; l < 4; ++l) {
        const int e = l >> 1;
        if (l > 0) { convert_layer(p, l, lds); if (PROBE_CONV) convert_layer(p, l, lds); GRID_SYNC(); }
        for (int f = 0; f < 2; ++f) {
#ifndef SKIP_MIX
#define SKIP_MIX 0
#endif
            if (f == 1 && !SKIP_MIX) {
                if ((l & 1) == 0) {
                  if (!SKIP_EVEN) {
                    {
                        PH_PTRS
                        pg8::Gemm g{xb, (const bf16*)(wb + W_IN), T, 2560, DM, DM}; pg8::StaticOrder S; S.init(T, 2560, G, blockIdx.x);
                        pg8::EpiInProj E{(bf16*)(ws + A_P01), (bf16*)(ws + A_QKV), (bf16*)(ws + A_Z), ctl + C_SSX, ctl + C_SSQ, ctl + C_SSKV};
                        pg8::gemm_phase(lds, g, S, E);
                        if (PROBE_INP) pg8::gemm_phase(lds, g, S, E);
                    }
                    GRID_SYNC();
                    {
                        PH_PTRS
                        pg8::Gemm g{(const bf16*)(ws + A_P01), (const bf16*)(wb + W_QB), T, 768, 256, 512}; pg8::StaticOrder S; S.init(T, 768, G, blockIdx.x);
                        pg8::EpiQ E{(bf16*)(ws + A_Q), ctl + C_SSQ};
                        pg8::gemm_phase(lds, g, S, E);
                        pg8::Gemm g2{(const bf16*)(ws + A_P01) + 256, (const bf16*)(wb + W_KVB), T, 1024, 256, 512}; pg8::StaticOrder S2; S2.init(T, 1024, G, blockIdx.x);
                        pg8::EpiKV E2{(bf16*)(ws + A_KP), (bf16*)(ws + A_V), ctl + C_SSKV};
                        pg8::gemm_phase(lds, g2, S2, E2);
                        if (PROBE_INP) { pg8::gemm_phase(lds, g, S, E); pg8::gemm_phase(lds, g2, S2, E2); }
                        gdn_pre(p, e);
                        if (PROBE_MISC) gdn_pre(p, e);
                    }
                    GRID_SYNC();
                    {
                        qk_prep(p, e);
                        gdn_prep(p, lds);
                        if (PROBE_MISC) gdn_prep(p, lds);
                    }
                    GRID_SYNC();
                    {
                        PH_PTRS
                        LAS int* qslot = (LAS int*)(lds + LDS_BYTES - 64);
                        for (int rep = 0; rep <= PROBE_E4; ++rep) {
                        int* ctr = (int*)(ctl + C_QCTR) + e * 64 + rep * 32;
                        for (;;) {
                            if (threadIdx.x == 0) *qslot = __hip_atomic_fetch_add(ctr, 1, __ATOMIC_RELAXED, __HIP_MEMORY_SCOPE_AGENT);
                            __syncthreads();
                            const int idx = *qslot;
                            __syncthreads();
                            if (idx >= 32 + 1024) break;
                            if (idx < 32 && ZERO_GDN) {
                                bf16* Yz = (bf16*)(ws + A_Y); const int zb = idx >> 3, zh = idx & 7;
                                const bf16* GQ_ = (const bf16*)(ws + A_GQ); const bf16* GK_ = (const bf16*)(ws + A_GK); const bf16* U_ = (const bf16*)(ws + A_U); const bf16* W_ = (const bf16*)(ws + A_WW); const float* GC_ = (const float*)(ws + A_GC);
                                for (int i = threadIdx.x; i < SEQ * 8; i += 512) { const int tk = i >> 3, sgm = i & 7; const size_t tok = (size_t)zb * SEQ + tk; const int nn = tk >> 6, rr = tk & 63;
                                    float a[8], b_[8], c_[8], d_[8], o_[8];
                                    unpack8(*(const u32x4*)(GQ_ + tok * 512 + zh * 64 + sgm * 8), a); unpack8(*(const u32x4*)(GK_ + tok * 512 + zh * 64 + sgm * 8), b_);
                                    unpack8(*(const u32x4*)(U_ + (((size_t)idx * 128 + nn) * 64 + rr) * 64 + sgm * 8), c_); unpack8(*(const u32x4*)(W_ + (((size_t)idx * 128 + nn) * 64 + rr) * 64 + sgm * 8), d_);
                                    const float gcv = GC_[((size_t)idx * 128 + nn) * 64 + rr]; unpack8(*(const u32x4*)((const bf16*)(ws + A_Z) + tok * 512 + zh * 64 + sgm * 8), a);
                                    for (int k = 0; k < 8; ++k) o_[k] = a[k] + b_[k] + c_[k] + d_[k] + 0.01f * gcv;
                                    *(u32x4*)(Yz + tok * 1024 + 512 + zh * 64 + sgm * 8) = pack8(o_); }
                            } else if (idx < 32) {
                                gdn_scan(lds, idx, (const bf16*)(ws + A_GQ), (const bf16*)(ws + A_GK), (const bf16*)(ws + A_U), (const bf16*)(ws + A_WW), (const float*)(ws + A_GC),
                                         (const bf16*)(ws + A_Z), (const float*)p.in[16] + e * 64, (bf16*)(ws + A_Y));
                            } else {
                                const int a = idx - 32, qb = 31 - (a >> 5), bh = a & 31;
                                if (ZERO_ATT) { bf16* Yz = (bf16*)(ws + A_Y); for (int i = threadIdx.x; i < 256 * 8; i += 512) { const int tk = i >> 3, sgm = i & 7; *(u32x4*)(Yz + ((size_t)(bh >> 3) * SEQ + qb * 256 + tk) * 1024 + (bh & 7) * 64 + sgm * 8) = (u32x4){0u, 0u, 0u, 0u}; } }
                                else attn_unit(lds, (const bf16*)(ws + A_Q), (const bf16*)(ws + A_KP), (const bf16*)(ws + A_V), (bf16*)(ws + A_Y), bh >> 3, bh & 7, qb);
                            }
                        }
                        }
                    }
                    GRID_SYNC();
                    {
                        PH_PTRS
                        pg8::Gemm g{(const bf16*)(ws + A_Y), (const bf16*)(wb + W_OUT), T, DM, DM, DM}; pg8::StaticOrder S; S.init(T, DM, G, blockIdx.x);
                        pg8::EpiResid E{xb, nullptr, ctl + C_SSX, 1.f};
                        pg8::gemm_phase(lds, g, S, E);
                    }
                    GRID_SYNC();
                  }
                } else {
                    {
                        PH_PTRS
                        pg8::Gemm g{xb, (const bf16*)(wb + W_SIN), T, 4096, DM, DM}; pg8::StaticOrder S; S.init(T, 4096, G, blockIdx.x);
                        pg8::EpiSgIn E{(bf16*)(ws + A_UV), ctl + C_SSX, (float*)(ws + A_SSV)};
                        pg8::gemm_phase(lds, g, S, E);
                        if (PROBE_INP) pg8::gemm_phase(lds, g, S, E);
                    }
                    GRID_SYNC();
                    sg_phase(p, e, lds);
                    if (PROBE_SG) sg_phase(p, e, lds);
                    GRID_SYNC();
                    {
                        PH_PTRS
                        pg8::Gemm g{(const bf16*)(ws + A_UG), (const bf16*)(wb + W_SOUT), T, DM, 2048, 2048}; pg8::StaticOrder S; S.init(T, DM, G, blockIdx.x);
                        pg8::EpiResid E{xb, nullptr, ctl + C_SSX, 1.f};
                        pg8::gemm_phase(lds, g, S, E);
                    }
                    GRID_SYNC();
                }
            }
            {
                        PH_PTRS
                pg8::Gemm g{xb, (const bf16*)(wb + (f == 0 ? W_1A : W_1B)), T, 2 * FF, DM, DM}; pg8::StaticOrder S; S.init(T, 2 * FF, G, blockIdx.x);
                pg8::EpiSwiglu E{(bf16*)(ws + A_H), ctl + C_SSX};
                pg8::gemm_phase(lds, g, S, E);
                if (PROBE_G1) pg8::gemm_phase(lds, g, S, E);
            }
            GRID_SYNC();
            {
                        PH_PTRS
                pg8::Gemm g{(const bf16*)(ws + A_H), (const bf16*)(wb + (f == 0 ? W_2A : W_2B)), T, DM, FF, FF}; pg8::StaticOrder S; S.init(T, DM, G, blockIdx.x);
                const bool lastg = (l == 3 && f == 1);
                pg8::EpiResid E{xb, lastg ? p.out : nullptr, lastg ? nullptr : ctl + C_SSX, 0.5f};
                pg8::gemm_phase(lds, g, S, E);
            }
            if (!(l == 3 && f == 1)) GRID_SYNC();
        }
    }
}

extern "C" void kernel_launch(void* const* d_in, const int* in_sizes, int n_in, void* d_out, int out_size, void* d_ws, size_t ws_size, hipStream_t stream) {
    static int grid = 0;
    if (grid == 0) {
        if (n_in != 23 || ws_size < WS_END) { fprintf(stderr, "kernel_launch: unexpected n_in %d or ws_size %zu\n", n_in, ws_size); grid = -1; return; }
        int dev = 0, cus = 0, per_cu = 0;
        hipGetDevice(&dev);
        hipDeviceGetAttribute(&cus, hipDeviceAttributeMultiprocessorCount, dev);
        if (hipFuncSetAttribute((const void*)mega_fwd, hipFuncAttributeMaxDynamicSharedMemorySize, LDS_BYTES) != hipSuccess) { fprintf(stderr, "kernel_launch: hipFuncSetAttribute failed\n"); grid = -1; return; }
        if (hipOccupancyMaxActiveBlocksPerMultiprocessor(&per_cu, (const void*)mega_fwd, 512, LDS_BYTES) != hipSuccess || per_cu < 1) { fprintf(stderr, "kernel_launch: occupancy query says %d\n", per_cu); per_cu = 1; }
        (void)hipGetLastError();
        grid = cus * 1;
    }
    if (grid < 0) return;
    if (hipMemsetAsync((char*)d_ws + WS_CTL + (size_t)C_BAR * 4, 0, 32768, stream) != hipSuccess) { fprintf(stderr, "kernel_launch: memset failed\n"); return; }
    Params p{};
    for (int i = 0; i < 23; ++i) p.in[i] = d_in[i];
    p.out = (float*)d_out; p.ws = (unsigned char*)d_ws;
    void* args[] = {&p};
    hipError_t e = hipLaunchCooperativeKernel((const void*)mega_fwd, dim3(grid), dim3(512), args, LDS_BYTES, stream);
    if (e != hipSuccess) fprintf(stderr, "cooperative launch failed: %s (grid %d)\n", hipGetErrorString(e), grid);
}
```

```cpp
#define SKIP_MIX 0
#ifndef PROBE_RES
#define PROBE_RES 0
#endif
#ifndef PROBE_INP
#define PROBE_INP 0
#endif
#ifndef PROBE_SYNC
#define PROBE_SYNC 0
#endif
#ifndef PROBE_MISC
#define PROBE_MISC 0
#endif
#ifndef PROBE_CONV
#define PROBE_CONV 0
#endif
#ifndef PROBE_E4
#define PROBE_E4 0
#endif
#ifndef PROBE_SG
#define PROBE_SG 0
#endif
#ifndef PROBE_G1
#define PROBE_G1 0
#endif
#define SKIP_EVEN 0
#define ZERO_GDN 0
#define ZERO_ATT 0
#include <hip/hip_runtime.h>
#include <hip/hip_cooperative_groups.h>
#include <cstdio>
#include <cstdint>
namespace cg = cooperative_groups;

#define LAS __attribute__((address_space(3)))
typedef unsigned short bf16;
typedef short bf16x8 __attribute__((ext_vector_type(8)));
typedef float f32x2 __attribute__((ext_vector_type(2)));
typedef float f32x4 __attribute__((ext_vector_type(4)));
typedef float f32x16 __attribute__((ext_vector_type(16)));
typedef unsigned u32x4 __attribute__((ext_vector_type(4)));
typedef unsigned u32x2 __attribute__((ext_vector_type(2)));

constexpr int T = 32768, DM = 1024, FF = 2816, SEQ = 8192, NB = 4;
constexpr float EPS = 1e-6f;
constexpr int LDS_BYTES = 147456;
constexpr size_t MiB = 1u << 20;
constexpr size_t WS_CTL = 0, WS_W = 8 * MiB, WS_XB = 56 * MiB, WS_ACT = 120 * MiB, WS_END = 512 * MiB;
constexpr size_t W_1A = 0, W_2A = 11534336, W_1B = 17301504, W_2B = 28835840, W_MIX = 34603008;
constexpr size_t W_IN = W_MIX, W_QB = W_MIX + 5242880, W_KVB = W_QB + 393216, W_OUT = W_KVB + 524288;
constexpr size_t W_SIN = W_MIX, W_SOUT = W_MIX + 8388608, W_SS = W_SOUT + 4194304;
constexpr size_t A_H = WS_ACT;
constexpr size_t A_QKV = WS_ACT, A_P01 = WS_ACT + 96 * MiB;
constexpr size_t A_U = WS_ACT, A_WW = WS_ACT + 32 * MiB, A_Y = WS_ACT + 64 * MiB;
constexpr size_t A_Z = WS_ACT + 128 * MiB, A_Q = WS_ACT + 160 * MiB, A_KP = WS_ACT + 208 * MiB, A_V = WS_ACT + 256 * MiB;
constexpr size_t A_GQ = WS_ACT + 288 * MiB, A_GK = WS_ACT + 320 * MiB, A_GV = WS_ACT + 352 * MiB;
constexpr size_t A_UV = WS_ACT, A_UG = WS_ACT + 256 * MiB;
constexpr int C_SSX = 0, C_SSQ = 524288, C_SSKV = 655360, C_BAR = 1048576, C_QCTR = 1048576 + 4096;
constexpr size_t A_SSV = WS_ACT + 384 * MiB;
constexpr size_t A_BETA = WS_ACT + 384 * MiB, A_GG = WS_ACT + 385 * MiB, A_GC = WS_ACT + 386 * MiB;

struct Params { const void* in[23]; float* out; unsigned char* ws; };

typedef __bf16 bf16x2_t __attribute__((ext_vector_type(2)));
__device__ __forceinline__ unsigned pk2(float lo, float hi) { const f32x2 v = {lo, hi}; const bf16x2_t b = __builtin_convertvector(v, bf16x2_t); return __builtin_bit_cast(unsigned, b); }
__device__ __forceinline__ float bflo(unsigned w) { return __uint_as_float(w << 16); }
__device__ __forceinline__ float bfhi(unsigned w) { return __uint_as_float(w & 0xffff0000u); }
__device__ __forceinline__ float bf2f(unsigned short b) { return __uint_as_float(((unsigned)b) << 16); }
__device__ __forceinline__ float wave_sum(float v) {
#pragma unroll
    for (int o = 1; o < 64; o <<= 1) v += __shfl_xor(v, o);
    return v;
}
__device__ __forceinline__ float sigmoidf_(float x) { return __builtin_amdgcn_rcpf(1.f + __expf(-x)); }
__device__ __forceinline__ float siluf_(float x) { return x * __builtin_amdgcn_rcpf(1.f + __expf(-x)); }
__device__ __forceinline__ void unpack8(const u32x4 v, float* f) {
    f[0] = bflo(v.x); f[1] = bfhi(v.x); f[2] = bflo(v.y); f[3] = bfhi(v.y); f[4] = bflo(v.z); f[5] = bfhi(v.z); f[6] = bflo(v.w); f[7] = bfhi(v.w);
}
__device__ __forceinline__ u32x4 pack8(const float* f) { u32x4 o; o.x = pk2(f[0], f[1]); o.y = pk2(f[2], f[3]); o.z = pk2(f[4], f[5]); o.w = pk2(f[6], f[7]); return o; }
__device__ __forceinline__ int otid() { int t = threadIdx.x; asm volatile("" : "+v"(t)); return t; }
template <class P_> __device__ __forceinline__ P_* opq(P_* q) { asm volatile("" : "+s"(q)); return q; }
__device__ __forceinline__ float sum16(const float* s) { const f32x4 a = *(const f32x4*)s, b = *(const f32x4*)(s + 4), c = *(const f32x4*)(s + 8), d = *(const f32x4*)(s + 12);
    return ((a[0] + a[1]) + (a[2] + a[3])) + ((b[0] + b[1]) + (b[2] + b[3])) + ((c[0] + c[1]) + (c[2] + c[3])) + ((d[0] + d[1]) + (d[2] + d[3])); }
__device__ __forceinline__ float sum4(const float* s) { const f32x4 a = *(const f32x4*)s; return (a[0] + a[1]) + (a[2] + a[3]); }
#define LDS_WAIT() asm volatile("s_waitcnt lgkmcnt(0)" ::: "memory")
__device__ __forceinline__ bf16x8 lds8(LAS const unsigned char* base, int row, int pitchB, int colElem) {
    return *(LAS const bf16x8*)(base + row * pitchB + colElem * 2);
}
__device__ __forceinline__ f32x4 mfma16(bf16x8 a, bf16x8 b, f32x4 c) { return __builtin_amdgcn_mfma_f32_16x16x32_bf16(a, b, c, 0, 0, 0); }

namespace pg8 {
constexpr int BM = 256, BK = 64, HALF = 128, HTB = HALF * BK * 2, STAGE_BYTES = 8 * HTB, NXCD = 8, WGM = 8;
__host__ __device__ __forceinline__ int lds_byte(int r, int c) { const int st = (r >> 4) * 2 + (c >> 5), rr = r & 15, cc = c & 31, ob = rr * 64 + cc * 2; return st * 1024 + (ob ^ (((ob >> 9) & 1) << 5)); }
__host__ __device__ __forceinline__ void stage_rc(int b, int& R, int& C) { const int st = b / 1024, sb = b % 1024, swz = sb ^ (((sb >> 9) & 1) << 5); R = (st >> 1) * 16 + swz / 64; C = (st & 1) * 32 + (swz % 64) / 2; }
__host__ __device__ __forceinline__ int perm32(int rho) { const int n = rho >> 4, i = rho & 15; return 8 * (i >> 2) + 4 * n + (i & 3); }
struct Unit { int pm, pn; };
struct Gemm { const bf16* A; const bf16* Bt; int M, N, K, lda; };
struct StaticOrder {
    int nM, nN, nwg, G, c;
    __device__ void init(int M, int N, int G_, int c_) { nM = M / BM; nN = N / BM; nwg = nM * nN; G = G_; c = c_; }
    __device__ bool next(int i, Unit& u) const {
        const long L = (long)i * G + c; if (L >= nwg) return false;
        int wgid = (int)L; { const int q = nwg / NXCD, r = nwg % NXCD, xcd = wgid % NXCD, off = wgid / NXCD; wgid = (xcd < r ? xcd * (q + 1) : r * (q + 1) + (xcd - r) * q) + off; }
        const int nig = WGM * nN, gid = wgid / nig, fm = gid * WGM, gsz = (nM - fm) < WGM ? (nM - fm) : WGM;
        u.pm = fm + ((wgid % nig) % gsz); u.pn = (wgid % nig) / gsz; return true;
    }
};
template <class Epi>
__device__ __forceinline__ void gemm_phase(LAS unsigned char* lds, const Gemm g, const StaticOrder& S, const Epi& E) {
    const int tid = otid(), wid = __builtin_amdgcn_readfirstlane(tid >> 6), lane = tid & 63, wr = wid >> 2, wc = wid & 3, fr = lane & 15, fq = lane >> 4;
    int K = g.K, lda = g.lda; asm volatile("" : "+s"(K), "+s"(lda)); const int nt = K / BK;
    unsigned voffA[2], voffB[2];
#pragma unroll
    for (int i = 0; i < 2; ++i) { int R, C; stage_rc(tid * 16 + i * 8192, R, C); const int Rb = (R & ~31) + perm32(R & 31);
        voffA[i] = (unsigned)(R * lda + C) * 2u; voffB[i] = (unsigned)(Rb * K + C) * 2u; }
    const size_t kstep = (size_t)(BK * 2);
    const size_t hstepA = (size_t)HALF * lda * 2, hstepB = (size_t)HALF * K * 2;
    const size_t tstepA = 2 * hstepA, tstepB = 2 * hstepB;
    const unsigned ldsw = (unsigned)wid * 1024u;
    const int aoff = lds_byte(wr * 64 + fr, fq * 8), boff = lds_byte(wc * 32 + fr, fq * 8);
#define PG8_SA(b, h) (((b) * 2 + (h)) * HTB)
#define PG8_SB(b, h) ((4 + (b) * 2 + (h)) * HTB)
#define PG8_STAGE(bufoff, gbase, voff) do { _Pragma("unroll") for (int _i = 0; _i < 2; ++_i) \
        __builtin_amdgcn_global_load_lds((const unsigned*)((const char*)(gbase) + (voff)[_i]), (LAS unsigned*)(lds + (bufoff) + ldsw + _i * 8192), 16, 0, 0); } while (0)
#define PG8_LDA(dst, b, h) do { _Pragma("unroll") for (int m = 0; m < 4; ++m) _Pragma("unroll") for (int k = 0; k < 2; ++k) dst[m][k] = *(const LAS bf16x8*)(lds + PG8_SA(b, h) + aoff + m * 2048 + k * 1024); } while (0)
#define PG8_LDB(dst, b, h) do { _Pragma("unroll") for (int n = 0; n < 2; ++n) _Pragma("unroll") for (int k = 0; k < 2; ++k) dst[n][k] = *(const LAS bf16x8*)(lds + PG8_SB(b, h) + boff + n * 2048 + k * 1024); } while (0)
#define PG8_MMA(ai, bj, At, Bt) do { __builtin_amdgcn_s_setprio(1); _Pragma("unroll") for (int m = 0; m < 4; ++m) _Pragma("unroll") for (int n = 0; n < 2; ++n) _Pragma("unroll") for (int k = 0; k < 2; ++k) \
        acc[ai][bj][m][n] = __builtin_amdgcn_mfma_f32_16x16x32_bf16(Bt[n][k], At[m][k], acc[ai][bj][m][n], 0, 0, 0); __builtin_amdgcn_s_setprio(0); } while (0)
#define PG8_WAIT_V(n) asm volatile("s_waitcnt vmcnt(" #n ")" ::: "memory")
#define PG8_WAIT_L(n) asm volatile("s_waitcnt lgkmcnt(" #n ")" ::: "memory")
#define PG8_BAR __builtin_amdgcn_s_barrier()
#define PG8_SCHED __builtin_amdgcn_sched_barrier(0)
    Unit cur, nxt; int ui = 0; int cpm = -1;
    if (!S.next(0, cur)) return;
    f32x4 acc[2][2][4][2];
#pragma unroll
    for (int a = 0; a < 2; ++a)
#pragma unroll
        for (int b = 0; b < 2; ++b)
#pragma unroll
            for (int m = 0; m < 4; ++m)
#pragma unroll
                for (int n = 0; n < 2; ++n) acc[a][b][m][n] = (f32x4){0.f, 0.f, 0.f, 0.f};
    bf16x8 At[4][2], B0[2][2], B1[2][2];
    const char* cA = (const char*)g.A + (size_t)cur.pm * tstepA; const char* cB = (const char*)g.Bt + (size_t)cur.pn * tstepB;
    PG8_STAGE(PG8_SB(0, 0), cB, voffB); PG8_STAGE(PG8_SB(0, 1), cB + hstepB, voffB); PG8_STAGE(PG8_SA(0, 0), cA, voffA); PG8_STAGE(PG8_SA(0, 1), cA + hstepA, voffA);
    if (wr == 1) PG8_BAR;
    PG8_WAIT_V(2); PG8_BAR;
    PG8_STAGE(PG8_SB(1, 0), cB + kstep, voffB); PG8_STAGE(PG8_SA(1, 0), cA + kstep, voffA); PG8_STAGE(PG8_SB(1, 1), cB + hstepB + kstep, voffB);
    PG8_WAIT_V(6); PG8_BAR;
    for (;;) {
        const bool has_next = S.next(ui + 1, nxt);
        const char* nA = has_next ? (const char*)g.A + (size_t)nxt.pm * tstepA : cA; const char* nB = has_next ? (const char*)g.Bt + (size_t)nxt.pn * tstepB : cB;
        for (int t = 0; t < nt; t += 2) {
            const bool last = (t == nt - 2);
            const char* a1 = cA + (size_t)(t + 1) * kstep;
            const char* a2 = last ? nA : cA + (size_t)(t + 2) * kstep; const char* b2 = last ? nB : cB + (size_t)(t + 2) * kstep;
            const char* a3 = a2 + kstep; const char* b3 = b2 + kstep;
            PG8_LDB(B0, 0, 0); PG8_LDB(B1, 0, 1); PG8_SCHED; PG8_LDA(At, 0, 0); PG8_STAGE(PG8_SA(1, 1), a1 + hstepA, voffA);
            PG8_WAIT_V(8); PG8_WAIT_L(0); PG8_BAR; PG8_MMA(0, 0, At, B0); PG8_MMA(0, 1, At, B1); PG8_BAR; PG8_SCHED;
            PG8_LDA(At, 0, 1); PG8_STAGE(PG8_SB(0, 0), b2, voffB); PG8_STAGE(PG8_SB(0, 1), b2 + hstepB, voffB); PG8_STAGE(PG8_SA(0, 0), a2, voffA);
            PG8_WAIT_V(8); PG8_WAIT_L(0); PG8_BAR; PG8_MMA(1, 0, At, B0); PG8_MMA(1, 1, At, B1); PG8_BAR; PG8_SCHED;
            PG8_LDB(B0, 1, 0); PG8_LDB(B1, 1, 1); PG8_SCHED; PG8_LDA(At, 1, 0); PG8_STAGE(PG8_SA(0, 1), a2 + hstepA, voffA);
            PG8_WAIT_V(8); PG8_WAIT_L(0); PG8_BAR; PG8_MMA(0, 0, At, B0); PG8_MMA(0, 1, At, B1); PG8_BAR; PG8_SCHED;
            PG8_LDA(At, 1, 1); PG8_STAGE(PG8_SB(1, 0), b3, voffB); PG8_STAGE(PG8_SB(1, 1), b3 + hstepB, voffB); PG8_STAGE(PG8_SA(1, 0), a3, voffA);
            PG8_WAIT_V(8); PG8_WAIT_L(0); PG8_BAR; PG8_MMA(1, 0, At, B0); PG8_MMA(1, 1, At, B1); PG8_BAR; PG8_SCHED;
        }
        if (wr == 0) PG8_BAR;
        if constexpr (Epi::RS_TAB) {
            if (cur.pm != cpm) {
                const int trow = tid >> 1, thalf = tid & 1;
                const float* sp = E.ss + (size_t)(cur.pm * BM + trow) * 16 + thalf * 8;
                const f32x4 s0 = *(const f32x4*)sp, s1 = *(const f32x4*)(sp + 4);
                float s = ((s0[0] + s0[1]) + (s0[2] + s0[3])) + ((s1[0] + s1[1]) + (s1[2] + s1[3]));
                s += __shfl_xor(s, 1);
                if (thalf == 0) *(LAS float*)(lds + STAGE_BYTES + trow * 4) = rsqrtf(s * (1.f / 1024.f) + EPS);
                PG8_WAIT_L(0); PG8_BAR;
                cpm = cur.pm;
            }
        }
        E(acc, cur, wr, wc, fr, fq, (LAS const float*)(lds + STAGE_BYTES));
        if (!has_next) break;
#pragma unroll
        for (int a = 0; a < 2; ++a)
#pragma unroll
            for (int b = 0; b < 2; ++b)
#pragma unroll
                for (int m = 0; m < 4; ++m)
#pragma unroll
                    for (int n = 0; n < 2; ++n) acc[a][b][m][n] = (f32x4){0.f, 0.f, 0.f, 0.f};
        cur = nxt; cA = nA; cB = nB; ++ui;
        if (wr == 1) PG8_BAR;
    }
    PG8_WAIT_V(0);
    PG8_BAR;
#undef PG8_SA
#undef PG8_SB
#undef PG8_STAGE
#undef PG8_LDA
#undef PG8_LDB
#undef PG8_MMA
#undef PG8_WAIT_V
#undef PG8_WAIT_L
#undef PG8_BAR
#undef PG8_SCHED
}
typedef f32x4 Acc[2][2][4][2];
__device__ __forceinline__ f32x2 gelu_pk(f32x2 v) {
    const f32x2 av = __builtin_elementwise_abs(v), d = av * 0.2316418882f + 1.0f;
    f32x2 t; t.x = __builtin_amdgcn_rcpf(d.x); t.y = __builtin_amdgcn_rcpf(d.y);
    f32x2 q = t * 0.5307027145f + (-0.7265760135f); q = q * t + 0.7107068705f; q = q * t + (-0.142248368f); q = q * t + 0.127414796f; q = q * t;
    const f32x2 s = (v * v) * (-0.72134752044f);
    f32x2 e; e.x = __builtin_amdgcn_exp2f(s.x); e.y = __builtin_amdgcn_exp2f(s.y);
    const f32x2 m = v * (q * e), r = v - m;
    f32x2 o; o.x = v.x < 0.f ? m.x : r.x; o.y = v.y < 0.f ? m.y : r.y; return o;
}

template <int NS> __device__ __forceinline__ void row_scales(const float* ss, int row0, int fq, float inv_n, float (&rs)[8]) {
    if constexpr (NS == 16) {
        f32x4 v[8];
#pragma unroll
        for (int i = 0; i < 8; ++i) v[i] = *(const f32x4*)(ss + (size_t)(row0 + (i >> 2) * HALF + (i & 3) * 16) * 16 + 4 * fq);
#pragma unroll
        for (int i = 0; i < 8; ++i) { float s = (v[i][0] + v[i][1]) + (v[i][2] + v[i][3]); s += __shfl_xor(s, 16); s += __shfl_xor(s, 32); rs[i] = rsqrtf(s * inv_n + EPS); }
    } else {
        float v[8];
#pragma unroll
        for (int i = 0; i < 8; ++i) v[i] = ss[(size_t)(row0 + (i >> 2) * HALF + (i & 3) * 16) * 4 + fq];
#pragma unroll
        for (int i = 0; i < 8; ++i) { float s = v[i]; s += __shfl_xor(s, 16); s += __shfl_xor(s, 32); rs[i] = rsqrtf(s * inv_n + EPS); }
    }
}
struct EpiSwiglu {
    static constexpr bool RS_TAB = true;
    bf16* H; const float* ss;
    __device__ __forceinline__ void operator()(const Acc& acc, const Unit& u, int wr, int wc, int fr, int fq, LAS const float* rtab) const {
        const int row0 = u.pm * BM + wr * 64 + fr;
        float rsv[8];
#pragma unroll
        for (int i = 0; i < 8; ++i) rsv[i] = rtab[wr * 64 + fr + (i >> 2) * HALF + (i & 3) * 16];
#pragma unroll
        for (int ai = 0; ai < 2; ++ai)
#pragma unroll
            for (int m = 0; m < 4; ++m) {
                const int row = row0 + ai * HALF + m * 16;
                const float rs = rsv[ai * 4 + m];
                float h[8];
#pragma unroll
                for (int n = 0; n < 2; ++n)
#pragma unroll
                    for (int j = 0; j < 4; ++j) { const float gg = acc[ai][0][m][n][j] * rs, uu = acc[ai][1][m][n][j] * rs; h[n * 4 + j] = siluf_(gg) * uu; }
                *(u32x4*)(H + (size_t)row * FF + u.pn * 128 + wc * 32 + 8 * fq) = pack8(h);
            }
    }
};
struct EpiResid {
    static constexpr bool RS_TAB = false;
    bf16* xb; float* fout; float* ssn; float alpha;
    __device__ __forceinline__ void operator()(const Acc& acc, const Unit& u, int wr, int wc, int fr, int fq, LAS const float* rtab) const {
        const int row0 = u.pm * BM + wr * 64 + fr;
        const size_t colb = (size_t)u.pn * BM + wc * 32 + 8 * fq;
#pragma unroll
        for (int ai = 0; ai < 2; ++ai) {
            u32x4 xv[4][2];
#pragma unroll
            for (int m = 0; m < 4; ++m)
#pragma unroll
                for (int bj = 0; bj < 2; ++bj) xv[m][bj] = *(const u32x4*)(xb + (size_t)(row0 + ai * HALF + m * 16) * DM + colb + bj * HALF);
#pragma unroll
            for (int m = 0; m < 4; ++m) {
                const int row = row0 + ai * HALF + m * 16;
                float s = 0.f;
#pragma unroll
                for (int bj = 0; bj < 2; ++bj) {
                    const size_t off = (size_t)row * DM + colb + bj * HALF;
                    float xf[8]; unpack8(xv[m][bj], xf);
                    float v[8];
#pragma unroll
                    for (int j = 0; j < 4; ++j) { v[j] = xf[j] + acc[ai][bj][m][0][j] * alpha; v[4 + j] = xf[4 + j] + acc[ai][bj][m][1][j] * alpha; }
                    if (fout) { *(f32x4*)(fout + off) = (f32x4){v[0], v[1], v[2], v[3]}; *(f32x4*)(fout + off + 4) = (f32x4){v[4], v[5], v[6], v[7]}; }
                    else *(u32x4*)(xb + off) = pack8(v);
#pragma unroll
                    for (int j = 0; j < 8; ++j) s += v[j] * v[j];
                }
                s += __shfl_xor(s, 16); s += __shfl_xor(s, 32);
                if (ssn && fq == 0) ssn[(size_t)row * 16 + u.pn * 4 + wc] = s;
            }
        }
    }
};
struct EpiInProj {
    static constexpr bool RS_TAB = true;
    bf16* P01; bf16* QKV; bf16* Z; const float* ss; float* ssq; float* sskv;
    __device__ __forceinline__ void operator()(const Acc& acc, const Unit& u, int wr, int wc, int fr, int fq, LAS const float* rtab) const {
        bf16* base; int ld, c0;
        if (u.pn < 2) { base = P01; ld = 512; c0 = u.pn * 256; } else if (u.pn < 8) { base = QKV; ld = 1536; c0 = (u.pn - 2) * 256; } else { base = Z; ld = 512; c0 = (u.pn - 8) * 256; }
        const int row0 = u.pm * BM + wr * 64 + fr;
        float rsv[8];
#pragma unroll
        for (int i = 0; i < 8; ++i) rsv[i] = rtab[wr * 64 + fr + (i >> 2) * HALF + (i & 3) * 16];
#pragma unroll
        for (int ai = 0; ai < 2; ++ai)
#pragma unroll
            for (int m = 0; m < 4; ++m) {
                const int row = row0 + ai * HALF + m * 16;
                const float rs = rsv[ai * 4 + m];
                float sq[2];
#pragma unroll
                for (int bj = 0; bj < 2; ++bj) {
                    float v[8]; float s = 0.f;
#pragma unroll
                    for (int n = 0; n < 2; ++n)
#pragma unroll
                        for (int j = 0; j < 4; ++j) { v[n * 4 + j] = acc[ai][bj][m][n][j] * rs; s += v[n * 4 + j] * v[n * 4 + j]; }
                    sq[bj] = s;
                    *(u32x4*)(base + (size_t)row * ld + c0 + bj * HALF + wc * 32 + 8 * fq) = pack8(v);
                }
                if (u.pn < 2) {
                    float s = (u.pn == 0) ? (sq[0] + sq[1]) : sq[0];
                    s += __shfl_xor(s, 16); s += __shfl_xor(s, 32);
                    if (fq == 0) (u.pn == 0 ? ssq : sskv)[(size_t)row * 4 + wc] = s;
                }
            }
    }
};
struct EpiQ {
    static constexpr bool RS_TAB = false;
    bf16* q; const float* ssq;
    __device__ __forceinline__ void operator()(const Acc& acc, const Unit& u, int wr, int wc, int fr, int fq, LAS const float* rtab) const {
        const int row0 = u.pm * BM + wr * 64 + fr;
        float rsv[8]; row_scales<4>(ssq, row0, fq, 1.f / 256.f, rsv);
#pragma unroll
        for (int ai = 0; ai < 2; ++ai)
#pragma unroll
            for (int m = 0; m < 4; ++m) {
                const int row = row0 + ai * HALF + m * 16;
                const float rs = rsv[ai * 4 + m];
#pragma unroll
                for (int bj = 0; bj < 2; ++bj) {
                    float v[8];
#pragma unroll
                    for (int n = 0; n < 2; ++n)
#pragma unroll
                        for (int j = 0; j < 4; ++j) v[n * 4 + j] = acc[ai][bj][m][n][j] * rs;
                    *(u32x4*)(q + (size_t)row * 768 + u.pn * 256 + bj * HALF + wc * 32 + 8 * fq) = pack8(v);
                }
            }
    }
};
struct EpiKV {
    static constexpr bool RS_TAB = false;
    bf16* Kp; bf16* V; const float* sskv;
    __device__ __forceinline__ void operator()(const Acc& acc, const Unit& u, int wr, int wc, int fr, int fq, LAS const float* rtab) const {
        const int row0 = u.pm * BM + wr * 64 + fr;
        float rsv[8]; row_scales<4>(sskv, row0, fq, 1.f / 128.f, rsv);
#pragma unroll
        for (int ai = 0; ai < 2; ++ai)
#pragma unroll
            for (int m = 0; m < 4; ++m) {
                const int row = row0 + ai * HALF + m * 16;
                const float rs = rsv[ai * 4 + m];
#pragma unroll
                for (int bj = 0; bj < 2; ++bj) {
                    float v[8];
#pragma unroll
                    for (int n = 0; n < 2; ++n)
#pragma unroll
                        for (int j = 0; j < 4; ++j) v[n * 4 + j] = acc[ai][bj][m][n][j] * rs;
                    const int head = 2 * u.pn + bj, c = wc * 32 + 8 * fq;
                    bf16* dst = (wc < 2) ? (Kp + (size_t)row * 768 + head * 96 + c) : (V + (size_t)row * 512 + head * 64 + (c - 64));
                    *(u32x4*)dst = pack8(v);
                }
            }
    }
};
struct EpiSgIn {
    static constexpr bool RS_TAB = true;
    bf16* UV; const float* ss; float* ssv;
    __device__ __forceinline__ void operator()(const Acc& acc, const Unit& u, int wr, int wc, int fr, int fq, LAS const float* rtab) const {
        const int row0 = u.pm * BM + wr * 64 + fr;
        float rsv[8];
#pragma unroll
        for (int i = 0; i < 8; ++i) rsv[i] = rtab[wr * 64 + fr + (i >> 2) * HALF + (i & 3) * 16];
#pragma unroll
        for (int ai = 0; ai < 2; ++ai)
#pragma unroll
            for (int m = 0; m < 4; ++m) {
                const int row = row0 + ai * HALF + m * 16;
                const float rs = rsv[ai * 4 + m];
                float s = 0.f;
#pragma unroll
                for (int bj = 0; bj < 2; ++bj) {
                    float v[8];
#pragma unroll
                    for (int n = 0; n < 2; ++n) {
                        const f32x4 a = acc[ai][bj][m][n] * rs;
                        const f32x2 g0 = gelu_pk((f32x2){a[0], a[1]}), g1 = gelu_pk((f32x2){a[2], a[3]});
                        v[n * 4 + 0] = g0.x; v[n * 4 + 1] = g0.y; v[n * 4 + 2] = g1.x; v[n * 4 + 3] = g1.y;
                    }
#pragma unroll
                    for (int j = 0; j < 8; ++j) s += v[j] * v[j];
                    *(u32x4*)(UV + (size_t)row * 4096 + u.pn * 256 + bj * HALF + wc * 32 + 8 * fq) = pack8(v);
                }
                if (u.pn >= 8) {
                    s += __shfl_xor(s, 16); s += __shfl_xor(s, 32);
                    if (fq == 0) ssv[((size_t)row * 8 + (u.pn - 8)) * 4 + wc] = s;
                }
            }
    }
};
}

__device__ __forceinline__ void conv_item(int kind, const float* W0, const float* W1, int ldw, int Kvalid, const float* ks, bf16* dst, int Kdst,
                                          LAS float* scr, int k0, int n0, int lane) {
    const int n = n0 + lane;
    const float* W = W0; int col = n;
    if (kind == 1) { const int tile = n >> 8, r = n & 255; col = (tile << 7) + (r & 127); W = (r < 128) ? W0 : W1; }
    else if (kind == 2) {
        if (n < 416) col = n; else if (n < 424) col = 2464 + (n - 416); else if (n < 432) col = 2472 + (n - 424); else if (n < 512) col = -1;
        else if (n < 2048) col = 416 + (n - 512); else col = 1952 + (n - 2048);
    }
    float cv[64];
#pragma unroll
    for (int i = 0; i < 64; ++i) {
        const int k = k0 + i;
        float v = 0.f;
        if (col >= 0 && k < Kvalid) { v = __builtin_nontemporal_load(W + (size_t)k * ldw + col); if (ks) v *= ks[k]; }
        cv[i] = v;
    }
#pragma unroll
    for (int i = 0; i < 64; ++i) scr[i * 65 + lane] = cv[i];
    LDS_WAIT();
    const int c = lane & 7;
#pragma unroll
    for (int jj = 0; jj < 8; ++jj) {
        const int nn = (lane >> 3) + 8 * jj; const LAS float* s = scr + (8 * c) * 65 + nn;
        u32x4 o; o.x = pk2(s[0 * 65], s[1 * 65]); o.y = pk2(s[2 * 65], s[3 * 65]); o.z = pk2(s[4 * 65], s[5 * 65]); o.w = pk2(s[6 * 65], s[7 * 65]);
        *(u32x4*)(dst + (size_t)(n0 + nn) * Kdst + k0 + 8 * c) = o;
    }
    LDS_WAIT();
}
__device__ __forceinline__ int conv_job(int start, int NGW, int kind, const float* W0, const float* W1, int ldw, int Kvalid, const float* ks, bf16* dst, int Kdst, int Ndst,
                                        LAS float* scr, int lane) {
    const int nkb = Kdst / 64, items = nkb * (Ndst / 64);
    int it = start;
    for (; it < items; it += NGW) { const int kb = it % nkb, nb = it / nkb; conv_item(kind, W0, W1, ldw, Kvalid, ks, dst, Kdst, scr, kb * 64, nb * 64, lane); }
    return it - items;
}
__device__ __forceinline__ void convert_layer(const Params& p, int l, LAS unsigned char* lds) {
    const int tid = otid(), lane = tid & 63, wid = tid >> 6, gw = blockIdx.x * 8 + wid, NGW = gridDim.x * 8;
    LAS float* scr = (LAS float*)(lds + wid * 16640);
    unsigned char* wb = opq(p.ws) + WS_W;
    const float* normw = (const float*)p.in[2] + (size_t)l * 3 * DM;
    const float* wg = (const float*)p.in[3] + (size_t)l * 2 * DM * FF;
    const float* wu = (const float*)p.in[4] + (size_t)l * 2 * DM * FF;
    const float* wd = (const float*)p.in[5] + (size_t)l * 2 * FF * DM;
    int st = gw;
    st = conv_job(st, NGW, 1, wg, wu, FF, DM, normw, (bf16*)(wb + W_1A), DM, 2 * FF, scr, lane);
    st = conv_job(st, NGW, 0, wd, nullptr, DM, FF, nullptr, (bf16*)(wb + W_2A), FF, DM, scr, lane);
    st = conv_job(st, NGW, 1, wg + (size_t)DM * FF, wu + (size_t)DM * FF, FF, DM, normw + 2 * DM, (bf16*)(wb + W_1B), DM, 2 * FF, scr, lane);
    st = conv_job(st, NGW, 0, wd + (size_t)FF * DM, nullptr, DM, FF, nullptr, (bf16*)(wb + W_2B), FF, DM, scr, lane);
    const int e = l >> 1;
    if ((l & 1) == 0) {
        st = conv_job(st, NGW, 2, (const float*)p.in[6] + (size_t)e * DM * 2480, nullptr, 2480, DM, normw + DM, (bf16*)(wb + W_IN), DM, 2560, scr, lane);
        st = conv_job(st, NGW, 0, (const float*)p.in[8] + (size_t)e * 256 * 768, nullptr, 768, 256, (const float*)p.in[7] + e * 256, (bf16*)(wb + W_QB), 256, 768, scr, lane);
        st = conv_job(st, NGW, 0, (const float*)p.in[10] + (size_t)e * 128 * 1024, nullptr, 1024, 128, (const float*)p.in[9] + e * 128, (bf16*)(wb + W_KVB), 256, 1024, scr, lane);
        st = conv_job(st, NGW, 0, (const float*)p.in[17] + (size_t)e * DM * DM, nullptr, DM, DM, nullptr, (bf16*)(wb + W_OUT), DM, DM, scr, lane);
    } else {
        st = conv_job(st, NGW, 0, (const float*)p.in[18] + (size_t)e * DM * 4096, nullptr, 4096, DM, normw + DM, (bf16*)(wb + W_SIN), DM, 4096, scr, lane);
        st = conv_job(st, NGW, 0, (const float*)p.in[22] + (size_t)e * 2048 * DM, nullptr, DM, 2048, nullptr, (bf16*)(wb + W_SOUT), 2048, DM, scr, lane);
        const float* wsrc = (const float*)p.in[20] + (size_t)e * 8 * 128 * 128; bf16* wdst = (bf16*)(wb + W_SS);
        for (int i = gw * 64 + lane; i < 8 * 128 * 128 / 2; i += NGW * 64) {
            const int e0 = 2 * i, jj = e0 & 127, ii = (e0 >> 7) & 127;
            const float a = (jj <= ii) ? wsrc[e0] : 0.f, b = (jj + 1 <= ii) ? wsrc[e0 + 1] : 0.f;
            ((unsigned*)wdst)[i] = pk2(a, b);
        }
    }
}

__device__ __forceinline__ int crow(int r, int hi) { return (r & 3) + 8 * (r >> 2) + 4 * hi; }
__device__ __forceinline__ void attn_unit(LAS unsigned char* lds, const bf16* Q, const bf16* Kp, const bf16* V, bf16* Y, int b, int h, int qb) {
    const int tid = otid(), lane = tid & 63, r32 = lane & 31, hi = lane >> 5; const int wid = __builtin_amdgcn_readfirstlane(tid >> 6);
    constexpr int KPB = 208, VPB = 136, KBUF = 64 * KPB, VBUF = 64 * VPB, KOFF = 0, VOFF = 2 * KBUF;
    const int q0 = qb * 256; const size_t rowbase = (size_t)b * SEQ;
    const bf16* qp = Q + (rowbase + q0 + wid * 32 + r32) * 768 + h * 96 + hi * 8;
    bf16x8 qr[6];
#pragma unroll
    for (int d0 = 0; d0 < 6; ++d0) qr[d0] = *(const bf16x8*)(qp + 16 * d0);
    const int NT = 4 * qb + 4;
    const int kv0 = tid / 12, kc0 = tid % 12, kv1 = (tid + 512) / 12, kc1 = (tid + 512) % 12;
    const bf16* kg = Kp + rowbase * 768 + h * 96;
    const bf16* vg = V + (rowbase + (tid & 63)) * 512 + h * 64 + 8 * (tid >> 6);
    u32x4 kreg0, kreg1 = (u32x4){0, 0, 0, 0}, vreg;
#define A_LOAD(t) do { kreg0 = *(const u32x4*)(kg + (size_t)((t) * 64 + kv0) * 768 + kc0 * 8); if (tid < 256) kreg1 = *(const u32x4*)(kg + (size_t)((t) * 64 + kv1) * 768 + kc1 * 8); \
        vreg = *(const u32x4*)(vg + (size_t)(t) * 64 * 512); } while (0)
#define A_STORE(buf) do { *(LAS u32x4*)(lds + KOFF + (buf) * KBUF + kv0 * KPB + kc0 * 16) = kreg0; if (tid < 256) *(LAS u32x4*)(lds + KOFF + (buf) * KBUF + kv1 * KPB + kc1 * 16) = kreg1; \
        LAS unsigned char* vb_ = lds + VOFF + (buf) * VBUF + (8 * (tid >> 6)) * VPB + 2 * (tid & 63); \
        *(LAS unsigned short*)(vb_ + 0 * VPB) = (unsigned short)(vreg.x & 0xffff); *(LAS unsigned short*)(vb_ + 1 * VPB) = (unsigned short)(vreg.x >> 16); \
        *(LAS unsigned short*)(vb_ + 2 * VPB) = (unsigned short)(vreg.y & 0xffff); *(LAS unsigned short*)(vb_ + 3 * VPB) = (unsigned short)(vreg.y >> 16); \
        *(LAS unsigned short*)(vb_ + 4 * VPB) = (unsigned short)(vreg.z & 0xffff); *(LAS unsigned short*)(vb_ + 5 * VPB) = (unsigned short)(vreg.z >> 16); \
        *(LAS unsigned short*)(vb_ + 6 * VPB) = (unsigned short)(vreg.w & 0xffff); *(LAS unsigned short*)(vb_ + 7 * VPB) = (unsigned short)(vreg.w >> 16); } while (0)
    A_LOAD(0); A_STORE(0);
    __syncthreads();
    float m_run = 0.f, l_run = 0.f;
    f32x16 o[2];
#pragma unroll
    for (int i = 0; i < 16; ++i) { o[0][i] = 0.f; o[1][i] = 0.f; }
    const int qrel = wid * 32 + r32;
    for (int t = 0; t < NT; ++t) {
        const int buf = t & 1;
        if (t + 1 < NT) A_LOAD(t + 1);
        const int jb = t - (NT - 4);
        const bool skip = (jb >= 0) && (64 * jb > wid * 32 + 31);
        if (!skip) {
            f32x16 p0, p1;
            const float nm = -m_run;
#pragma unroll
            for (int i = 0; i < 16; ++i) { p0[i] = nm; p1[i] = nm; }
            LAS const unsigned char* kb = lds + KOFF + buf * KBUF + r32 * KPB + hi * 16;
            LAS const unsigned char* vb = lds + VOFF + buf * VBUF + r32 * VPB + hi * 8;
#pragma unroll
            for (int d0 = 0; d0 < 6; ++d0) p0 = __builtin_amdgcn_mfma_f32_32x32x16_bf16(*(LAS const bf16x8*)(kb + 32 * d0), qr[d0], p0, 0, 0, 0);
#pragma unroll
            for (int d0 = 0; d0 < 6; ++d0) p1 = __builtin_amdgcn_mfma_f32_32x32x16_bf16(*(LAS const bf16x8*)(kb + 32 * KPB + 32 * d0), qr[d0], p1, 0, 0, 0);
#define ATT_HALF(P, KOFS, S0) do { \
            if (jb >= 0) { _Pragma("unroll") for (int r = 0; r < 16; ++r) { const int kv = 64 * jb + (KOFS) + crow(r, hi); if (kv > qrel) P[r] = -INFINITY; } } \
            float mxa = __builtin_fmaxf(__builtin_fmaxf(P[0], P[1]), P[2]), mxb = __builtin_fmaxf(__builtin_fmaxf(P[3], P[4]), P[5]); \
            mxa = __builtin_fmaxf(__builtin_fmaxf(mxa, P[6]), P[7]); mxb = __builtin_fmaxf(__builtin_fmaxf(mxb, P[8]), P[9]); \
            mxa = __builtin_fmaxf(__builtin_fmaxf(mxa, P[10]), P[11]); mxb = __builtin_fmaxf(__builtin_fmaxf(mxb, P[12]), P[13]); \
            mxa = __builtin_fmaxf(__builtin_fmaxf(mxa, P[14]), P[15]); float mx = __builtin_fmaxf(mxa, mxb); \
            { auto rr = __builtin_amdgcn_permlane32_swap(__float_as_uint(mx), __float_as_uint(mx), false, false); mx = fmaxf(__uint_as_float(rr[0]), __uint_as_float(rr[1])); } \
            const float dl = (t == 0 && (KOFS) == 0) ? mx : fmaxf(mx, 0.f); \
            if (__builtin_amdgcn_ballot_w64(dl != 0.f) != 0ull) { \
                const float alpha = __builtin_amdgcn_exp2f(-dl); \
                m_run += dl; l_run *= alpha; \
                _Pragma("unroll") for (int r = 0; r < 16; ++r) P[r] -= dl; \
                if ((KOFS) == 0) { _Pragma("unroll") for (int r = 0; r < 16; ++r) p1[r] -= dl; } \
                _Pragma("unroll") for (int i = 0; i < 16; ++i) { o[0][i] *= alpha; o[1][i] *= alpha; } \
            } \
            float ls0 = 0.f, ls1 = 0.f; \
            _Pragma("unroll") for (int r = 0; r < 16; r += 2) { P[r] = __builtin_amdgcn_exp2f(P[r]); P[r + 1] = __builtin_amdgcn_exp2f(P[r + 1]); ls0 += P[r]; ls1 += P[r + 1]; } \
            l_run += ls0 + ls1; \
            const u32x4 pwa = (u32x4){pk2(P[0], P[1]), pk2(P[2], P[3]), pk2(P[4], P[5]), pk2(P[6], P[7])}; \
            const u32x4 pwb = (u32x4){pk2(P[8], P[9]), pk2(P[10], P[11]), pk2(P[12], P[13]), pk2(P[14], P[15])}; \
            _Pragma("unroll") for (int d = 0; d < 2; ++d) { \
                const u32x2 lo0 = *(LAS const u32x2*)(vb + d * 32 * VPB + (S0) * 32), hh0 = *(LAS const u32x2*)(vb + d * 32 * VPB + (S0) * 32 + 16); \
                const u32x2 lo1 = *(LAS const u32x2*)(vb + d * 32 * VPB + ((S0) + 1) * 32), hh1 = *(LAS const u32x2*)(vb + d * 32 * VPB + ((S0) + 1) * 32 + 16); \
                o[d] = __builtin_amdgcn_mfma_f32_32x32x16_bf16(__builtin_bit_cast(bf16x8, ((u32x4){lo0.x, lo0.y, hh0.x, hh0.y})), __builtin_bit_cast(bf16x8, pwa), o[d], 0, 0, 0); \
                o[d] = __builtin_amdgcn_mfma_f32_32x32x16_bf16(__builtin_bit_cast(bf16x8, ((u32x4){lo1.x, lo1.y, hh1.x, hh1.y})), __builtin_bit_cast(bf16x8, pwb), o[d], 0, 0, 0); \
            } } while (0)
            ATT_HALF(p0, 0, 0);
            ATT_HALF(p1, 32, 2);
#undef ATT_HALF
        }
        if (t + 1 < NT) A_STORE(buf ^ 1);
        __syncthreads();
    }
#undef A_LOAD
#undef A_STORE
    const float lt = l_run + __shfl_xor(l_run, 32);
    const float inv = 1.f / lt;
    bf16* yp = Y + (rowbase + q0 + wid * 32 + r32) * 1024 + h * 64;
#pragma unroll
    for (int d = 0; d < 2; ++d)
#pragma unroll
        for (int g4 = 0; g4 < 4; ++g4) {
            u32x2 w; w.x = pk2(o[d][4 * g4 + 0] * inv, o[d][4 * g4 + 1] * inv); w.y = pk2(o[d][4 * g4 + 2] * inv, o[d][4 * g4 + 3] * inv);
            *(u32x2*)(yp + 32 * d + 8 * g4 + 4 * hi) = w;
        }
}

__device__ __forceinline__ void gdn_scan(LAS unsigned char* lds, int bh, const bf16* GQ, const bf16* GK, const bf16* U, const bf16* W, const float* GC, const bf16* Z,
                                         const float* onorm, bf16* Y) {
    const int tid = otid(), lane = tid & 63, l15 = lane & 15, l4 = lane >> 4; const int wid = __builtin_amdgcn_readfirstlane(tid >> 6);
    const int b = bh >> 3, h = bh & 7;
    constexpr int PB = 144, QL = 0, KL = 9216, WL = 18432, ST = 27648, VNT = 36864, VNST = 46080, ATT = 55296, KT0 = 64512, OL = 82944, GCL = 100352, OPB = 272;
    const int tb = wid >> 1, db0 = (wid & 1) * 2;
    f32x4 Sacc[2] = {(f32x4){0.f, 0.f, 0.f, 0.f}, (f32x4){0.f, 0.f, 0.f, 0.f}};
    for (int i = tid; i < 9216 / 4; i += 512) *(LAS unsigned*)(lds + ST + i * 4) = 0u;
    const size_t cbase = (size_t)bh * 128;
    const int orow = tid >> 3, oseg = tid & 7;
    u32x4 pq[2], pk_[2], pw_[2], pz[2]; float pgc[2] = {0.f, 0.f}; unsigned short pu[2][2][4];
#define G_LOAD(n, S) do { const size_t tok = (size_t)b * SEQ + (size_t)(n) * 64 + lane; \
        pq[S] = *(const u32x4*)(GQ + tok * 512 + h * 64 + wid * 8); pk_[S] = *(const u32x4*)(GK + tok * 512 + h * 64 + wid * 8); \
        pw_[S] = *(const u32x4*)(W + ((cbase + (n)) * 64 + lane) * 64 + wid * 8); \
        pz[S] = *(const u32x4*)(Z + ((size_t)b * SEQ + (size_t)(n) * 64 + orow) * 512 + h * 64 + oseg * 8); \
        if (tid < 64) pgc[S] = GC[(cbase + (n)) * 64 + tid]; \
        _Pragma("unroll") for (int d = 0; d < 2; ++d) _Pragma("unroll") for (int r = 0; r < 4; ++r) pu[S][d][r] = U[((cbase + (n)) * 64 + 16 * tb + 4 * l4 + r) * 64 + 16 * (db0 + d) + l15]; } while (0)
#define G_STORE(n, S) do { *(LAS u32x4*)(lds + QL + lane * PB + wid * 16) = pq[S]; *(LAS u32x4*)(lds + KL + lane * PB + wid * 16) = pk_[S]; *(LAS u32x4*)(lds + WL + lane * PB + wid * 16) = pw_[S]; \
        LAS unsigned char* kt_ = lds + KT0 + ((n) & 1) * 9216 + (wid * 8) * PB + lane * 2; \
        *(LAS unsigned short*)(kt_ + 0 * PB) = (unsigned short)(pk_[S].x & 0xffff); *(LAS unsigned short*)(kt_ + 1 * PB) = (unsigned short)(pk_[S].x >> 16); \
        *(LAS unsigned short*)(kt_ + 2 * PB) = (unsigned short)(pk_[S].y & 0xffff); *(LAS unsigned short*)(kt_ + 3 * PB) = (unsigned short)(pk_[S].y >> 16); \
        *(LAS unsigned short*)(kt_ + 4 * PB) = (unsigned short)(pk_[S].z & 0xffff); *(LAS unsigned short*)(kt_ + 5 * PB) = (unsigned short)(pk_[S].z >> 16); \
        *(LAS unsigned short*)(kt_ + 6 * PB) = (unsigned short)(pk_[S].w & 0xffff); *(LAS unsigned short*)(kt_ + 7 * PB) = (unsigned short)(pk_[S].w >> 16); \
        if (tid < 64) *(LAS float*)(lds + GCL + tid * 4) = pgc[S]; \
        _Pragma("unroll") for (int d = 0; d < 2; ++d) _Pragma("unroll") for (int r = 0; r < 4; ++r) uc[d][r] = bf2f(pu[S][d][r]); \
        z_norm = z_pend; z_pend = pz[S]; } while (0)
    float uc[2][4];
    u32x4 z_norm = (u32x4){0u, 0u, 0u, 0u}, z_pend = z_norm;
    G_LOAD(0, 0);
    G_STORE(0, 0);
    G_LOAD(1, 1);
    __syncthreads();
    float onw[8];
#pragma unroll
    for (int e = 0; e < 8; ++e) onw[e] = onorm[oseg * 8 + e];
#define SCAN_COMPUTE(NN) do { \
        f32x4 pacc[2], qs[2], at[2]; \
_Pragma("unroll") \
        for (int d = 0; d < 2; ++d) { pacc[d] = (f32x4){0.f, 0.f, 0.f, 0.f}; qs[d] = pacc[d]; at[d] = pacc[d]; } \
_Pragma("unroll") \
        for (int ks = 0; ks < 2; ++ks) { \
            const bf16x8 aw = lds8(lds + WL, 16 * tb + l15, PB, 32 * ks + 8 * l4), aq = lds8(lds + QL, 16 * tb + l15, PB, 32 * ks + 8 * l4); \
_Pragma("unroll") \
            for (int d = 0; d < 2; ++d) { \
                const bf16x8 bs = lds8(lds + ST, 16 * (db0 + d) + l15, PB, 32 * ks + 8 * l4), bk = lds8(lds + KL, 16 * (db0 + d) + l15, PB, 32 * ks + 8 * l4); \
                pacc[d] = mfma16(aw, bs, pacc[d]); qs[d] = mfma16(aq, bs, qs[d]); at[d] = mfma16(aq, bk, at[d]); \
            } \
        } \
        float gci[4]; \
_Pragma("unroll") \
        for (int r = 0; r < 4; ++r) gci[r] = *(LAS const float*)(lds + GCL + (16 * tb + 4 * l4 + r) * 4); \
        const float glast = *(LAS const float*)(lds + GCL + 63 * 4); \
        const float eg = __expf(glast); \
_Pragma("unroll") \
        for (int d = 0; d < 2; ++d) { \
            float vn[4], vs[4]; \
_Pragma("unroll") \
            for (int r = 0; r < 4; ++r) { vn[r] = uc[d][r] - pacc[d][r]; vs[r] = vn[r] * __expf(glast - gci[r]); } \
            const int dvrow = 16 * (db0 + d) + l15; \
            *(LAS u32x2*)(lds + VNT + dvrow * PB + (16 * tb + 4 * l4) * 2) = (u32x2){pk2(vn[0], vn[1]), pk2(vn[2], vn[3])}; \
            *(LAS u32x2*)(lds + VNST + dvrow * PB + (16 * tb + 4 * l4) * 2) = (u32x2){pk2(vs[0], vs[1]), pk2(vs[2], vs[3])}; \
            const int j = 16 * (db0 + d) + l15; const float gcj = *(LAS const float*)(lds + GCL + j * 4); \
_Pragma("unroll") \
            for (int r = 0; r < 4; ++r) { \
                const int i = 16 * tb + 4 * l4 + r; \
                const float val = (j <= i) ? at[d][r] * __expf(gci[r] - gcj) : 0.f; \
                *(LAS unsigned short*)(lds + ATT + i * PB + j * 2) = (unsigned short)(pk2(val, 0.f) & 0xffff); \
                qs[d][r] *= __expf(gci[r]); \
            } \
        } \
        if ((NN) > 0) { \
            const f32x4 o0 = *(LAS const f32x4*)(lds + OL + orow * OPB + oseg * 32), o1 = *(LAS const f32x4*)(lds + OL + orow * OPB + oseg * 32 + 16); \
            float ss = (o0[0] * o0[0] + o0[1] * o0[1]) + (o0[2] * o0[2] + o0[3] * o0[3]) + (o1[0] * o1[0] + o1[1] * o1[1]) + (o1[2] * o1[2] + o1[3] * o1[3]); \
            ss += __shfl_xor(ss, 1); ss += __shfl_xor(ss, 2); ss += __shfl_xor(ss, 4); \
            const float rs = rsqrtf(ss * (1.f / 64.f) + EPS); \
            const size_t tok = (size_t)b * SEQ + (size_t)((NN) - 1) * 64 + orow; \
            const u32x4 zr = z_norm; \
            float zf[8], of[8] = {o0[0], o0[1], o0[2], o0[3], o1[0], o1[1], o1[2], o1[3]}; \
            unpack8(zr, zf); \
_Pragma("unroll") \
            for (int e = 0; e < 8; ++e) of[e] = of[e] * rs * onw[e] * siluf_(zf[e]); \
            *(u32x4*)(Y + tok * 1024 + 512 + h * 64 + oseg * 8) = pack8(of); \
        } \
        __syncthreads(); \
_Pragma("unroll") \
        for (int ks = 0; ks < 2; ++ks) { \
            const bf16x8 aa = lds8(lds + ATT, 16 * tb + l15, PB, 32 * ks + 8 * l4), ak = lds8(lds + KT0 + ((NN) & 1) * 9216, 16 * tb + l15, PB, 32 * ks + 8 * l4); \
_Pragma("unroll") \
            for (int d = 0; d < 2; ++d) { \
                const bf16x8 bv = lds8(lds + VNT, 16 * (db0 + d) + l15, PB, 32 * ks + 8 * l4), bvs = lds8(lds + VNST, 16 * (db0 + d) + l15, PB, 32 * ks + 8 * l4); \
                qs[d] = mfma16(aa, bv, qs[d]); \
                if (ks == 0) Sacc[d] = Sacc[d] * eg; \
                Sacc[d] = mfma16(ak, bvs, Sacc[d]); \
            } \
        } \
_Pragma("unroll") \
        for (int d = 0; d < 2; ++d) { \
_Pragma("unroll") \
            for (int r = 0; r < 4; ++r) *(LAS float*)(lds + OL + (16 * tb + 4 * l4 + r) * OPB + (16 * (db0 + d) + l15) * 4) = qs[d][r]; \
            *(LAS u32x2*)(lds + ST + (16 * (db0 + d) + l15) * PB + (16 * tb + 4 * l4) * 2) = (u32x2){pk2(Sacc[d][0], Sacc[d][1]), pk2(Sacc[d][2], Sacc[d][3])}; \
        } \
    } while (0)
#define SCAN_STEP(NN, SL, SS) do { \
        if ((NN) + 2 < 128) G_LOAD((NN) + 2, SL); \
        SCAN_COMPUTE(NN); \
        if ((NN) + 1 < 128) G_STORE((NN) + 1, SS); else { z_norm = z_pend; } \
        __syncthreads(); } while (0)
    for (int n = 0; n < 128; n += 2) {
        SCAN_STEP(n, 0, 1);
        SCAN_STEP(n + 1, 1, 0);
    }
#undef SCAN_STEP
#undef SCAN_COMPUTE
#undef G_LOAD
#undef G_STORE
    {
        const f32x4 o0 = *(LAS const f32x4*)(lds + OL + orow * OPB + oseg * 32), o1 = *(LAS const f32x4*)(lds + OL + orow * OPB + oseg * 32 + 16);
        float ss = (o0[0] * o0[0] + o0[1] * o0[1]) + (o0[2] * o0[2] + o0[3] * o0[3]) + (o1[0] * o1[0] + o1[1] * o1[1]) + (o1[2] * o1[2] + o1[3] * o1[3]);
        ss += __shfl_xor(ss, 1); ss += __shfl_xor(ss, 2); ss += __shfl_xor(ss, 4);
        const float rs = rsqrtf(ss * (1.f / 64.f) + EPS);
        const size_t tok = (size_t)b * SEQ + (size_t)127 * 64 + orow;
        const u32x4 zr = z_norm;
        float zf[8], of[8] = {o0[0], o0[1], o0[2], o0[3], o1[0], o1[1], o1[2], o1[3]};
        unpack8(zr, zf);
#pragma unroll
        for (int e = 0; e < 8; ++e) of[e] = of[e] * rs * onw[e] * siluf_(zf[e]);
        *(u32x4*)(Y + tok * 1024 + 512 + h * 64 + oseg * 8) = pack8(of);
    }
    __syncthreads();
}

__device__ __forceinline__ void gdn_pre(const Params& p, int e) {
    const int tid = otid(), lane = tid & 63, gw = blockIdx.x * 8 + (tid >> 6), NGW = gridDim.x * 8;
    unsigned char* ws = opq(p.ws);
    const bf16* QKV = (const bf16*)(ws + A_QKV); const bf16* P01 = (const bf16*)(ws + A_P01);
    bf16* GQ = (bf16*)(ws + A_GQ); bf16* GK = (bf16*)(ws + A_GK); bf16* GV = (bf16*)(ws + A_GV);
    const float* cw = (const float*)p.in[13] + (size_t)e * 4 * 1536;
    const float* alog = (const float*)p.in[14] + e * 8; const float* dtb = (const float*)p.in[15] + e * 8;
    for (int blk = gw; blk < T / 16; blk += NGW) {
        const int t0 = blk * 16, s0 = t0 & (SEQ - 1);
#pragma unroll 1
        for (int part = 0; part < 3; ++part) {
            const int c0 = part * 512 + lane * 8;
            u32x4 xr[19];
#pragma unroll
            for (int i = 0; i < 19; ++i) xr[i] = (s0 + i - 3 >= 0) ? *(const u32x4*)(QKV + (size_t)(t0 + i - 3) * 1536 + c0) : (u32x4){0u, 0u, 0u, 0u};
            float w[4][8];
#pragma unroll
            for (int j = 0; j < 4; ++j) { const f32x4 w0 = *(const f32x4*)(cw + j * 1536 + c0), w1 = *(const f32x4*)(cw + j * 1536 + c0 + 4);
                w[j][0] = w0[0]; w[j][1] = w0[1]; w[j][2] = w0[2]; w[j][3] = w0[3]; w[j][4] = w1[0]; w[j][5] = w1[1]; w[j][6] = w1[2]; w[j][7] = w1[3]; }
            bf16* dstb = (part == 0 ? GQ : (part == 1 ? GK : GV)) + (size_t)t0 * 512 + lane * 8;
#pragma unroll
            for (int i = 0; i < 16; ++i) {
                float acc[8];
#pragma unroll
                for (int k = 0; k < 8; ++k) acc[k] = 0.f;
#pragma unroll
                for (int j = 0; j < 4; ++j) { float xf[8]; unpack8(xr[i + j], xf);
#pragma unroll
                    for (int k = 0; k < 8; ++k) acc[k] += xf[k] * w[j][k]; }
                float ss = 0.f;
#pragma unroll
                for (int k = 0; k < 8; ++k) { acc[k] = siluf_(acc[k]); ss += acc[k] * acc[k]; }
                if (part < 2) {
                    ss += __shfl_xor(ss, 1); ss += __shfl_xor(ss, 2); ss += __shfl_xor(ss, 4);
                    const float sc = rsqrtf(ss + EPS) * (part == 0 ? 0.125f : 1.f);
#pragma unroll
                    for (int k = 0; k < 8; ++k) acc[k] *= sc;
                }
                *(u32x4*)(dstb + (size_t)i * 512) = pack8(acc);
            }
        }
#pragma unroll
        for (int k2 = 0; k2 < 2; ++k2) {
            const int idx = lane + 64 * k2, tk = idx >> 3, hh = idx & 7; const size_t t = (size_t)t0 + tk;
            const float bl = bf2f(P01[t * 512 + 416 + hh]);
            ((float*)(ws + A_BETA))[t * 8 + hh] = sigmoidf_(bl);
            const float x = bf2f(P01[t * 512 + 424 + hh]) + dtb[hh];
            const float ex = __expf(x); const float sp = (x > 20.f) ? x : (ex < 0.01f ? ex * (1.f - ex * (0.5f - ex * (1.f / 3.f))) : __logf(1.f + ex));
            ((float*)(ws + A_GG))[t * 8 + hh] = -__expf(alog[hh]) * sp;
        }
    }
}

__device__ __forceinline__ void gdn_prep(const Params& p, LAS unsigned char* lds) {
    const int tid = otid(), lane = tid & 63, l15 = lane & 15, l4 = lane >> 4, sg = tid >> 7, st = tid & 127, w2 = (tid >> 6) & 1;
    unsigned char* ws = opq(p.ws);
    const bf16* GK = (const bf16*)(ws + A_GK); const bf16* GV = (const bf16*)(ws + A_GV);
    bf16* U = (bf16*)(ws + A_U); bf16* W = (bf16*)(ws + A_WW);
    float* ctl = (float*)(ws + WS_CTL);
    LAS unsigned char* L = lds + sg * 36864;
    constexpr int PB = 144, KL2 = 0, VL = 9216, AF = 18432, GCX = 35840, BEX = 36096, EWX = 36352;
    for (int base = blockIdx.x * 4; base < 4096; base += gridDim.x * 4) {
        const int task = base + sg, bh = task >> 7, n = task & 127, b = bh >> 3, h = bh & 7;
        const size_t tok0 = (size_t)b * SEQ + (size_t)n * 64;
#pragma unroll
        for (int i = 0; i < 4; ++i) { const int idx = st + 128 * i, row = idx >> 3, ch = idx & 7;
            *(LAS u32x4*)(L + KL2 + row * PB + ch * 16) = *(const u32x4*)(GK + (tok0 + row) * 512 + h * 64 + ch * 8);
            *(LAS u32x4*)(L + VL + row * PB + ch * 16) = *(const u32x4*)(GV + (tok0 + row) * 512 + h * 64 + ch * 8); }
        if (st < 64) {
            const float be = ((const float*)(ws + A_BETA))[(tok0 + st) * 8 + h]; float gg = ((const float*)(ws + A_GG))[(tok0 + st) * 8 + h];
#pragma unroll
            for (int off = 1; off < 64; off <<= 1) { const float tt = __shfl_up(gg, off); if (lane >= off) gg += tt; }
            *(LAS float*)(L + GCX + st * 4) = gg; *(LAS float*)(L + BEX + st * 4) = be; *(LAS float*)(L + EWX + st * 4) = be * __expf(gg);
            ((float*)(ws + A_GC))[((size_t)bh * 128 + n) * 64 + st] = gg;
        }
        __syncthreads();
#pragma unroll 1
        for (int k = 0; k < 8; ++k) {
            const int t16 = w2 * 8 + k, ti = t16 >> 2, tj = t16 & 3;
            f32x4 acc = (f32x4){0.f, 0.f, 0.f, 0.f};
            if (tj <= ti) {
#pragma unroll
                for (int ks = 0; ks < 2; ++ks) acc = mfma16(lds8(L + KL2, 16 * ti + l15, PB, 32 * ks + 8 * l4), lds8(L + KL2, 16 * tj + l15, PB, 32 * ks + 8 * l4), acc);
            }
            const int j = 16 * tj + l15; const float gcj = *(LAS const float*)(L + GCX + j * 4);
#pragma unroll
            for (int r = 0; r < 4; ++r) {
                const int i = 16 * ti + 4 * l4 + r;
                const float gi = *(LAS const float*)(L + GCX + i * 4), bi = *(LAS const float*)(L + BEX + i * 4);
                const float val = (j < i) ? bi * acc[r] * __expf(gi - gcj) : 0.f;
                *(LAS float*)(L + AF + (i * 68 + j) * 4) = val;
            }
        }
        __syncthreads();
        {
            const int c = st & 63; const bool isw = st >= 64;
            LAS const unsigned char* rb = L + (isw ? KL2 : VL) + c * 2;
            LAS const unsigned char* sb = L + (isw ? EWX : BEX);
            float x[64];
#pragma unroll
            for (int i = 0; i < 64; ++i) {
                float a0 = bf2f(*(LAS const unsigned short*)(rb + i * PB)) * *(LAS const float*)(sb + i * 4), a1 = 0.f;
#pragma unroll
                for (int j4 = 0; j4 < (i + 3) / 4; ++j4) {
                    const f32x4 av = *(LAS const f32x4*)(L + AF + (i * 68 + j4 * 4) * 4);
#pragma unroll
                    for (int jj = 0; jj < 4; ++jj) if (j4 * 4 + jj < i) { if (jj & 1) a1 -= av[jj] * x[j4 * 4 + jj]; else a0 -= av[jj] * x[j4 * 4 + jj]; }
                }
                x[i] = a0 + a1;
                asm volatile("" ::: "memory");
            }
            bf16* dst = (isw ? W : U) + ((size_t)bh * 128 + n) * 4096 + c;
#pragma unroll
            for (int i = 0; i < 64; ++i) dst[i * 64] = (unsigned short)(pk2(x[i], 0.f) & 0xffff);
        }
        __syncthreads();
    }
}

__device__ __forceinline__ void qk_prep(const Params& p, int e) {
    const int tid = otid(), lane = tid & 63, gw = blockIdx.x * 8 + (tid >> 6), NGW = gridDim.x * 8;
    unsigned char* ws = opq(p.ws);
    bf16* Q = (bf16*)(ws + A_Q); bf16* Kp = (bf16*)(ws + A_KP); const bf16* P01 = (const bf16*)(ws + A_P01);
    const int* pos = (const int*)p.in[1];
    const float* wq = (const float*)p.in[11] + e * 96; const float* wk = (const float*)p.in[12] + e * 96;
    const int sub = lane & 7, hh = lane >> 3;
    const float C2 = 0.10206207261596577f * 1.4426950408889634f;
    float wqn[8], wkn[8], wqr[4], wkr[4];
#pragma unroll
    for (int k = 0; k < 8; ++k) { wqn[k] = wq[8 * sub + k]; wkn[k] = wk[8 * sub + k]; }
    wqr[0] = wq[64 + 2 * sub]; wqr[1] = wq[65 + 2 * sub]; wqr[2] = wq[80 + 2 * sub]; wqr[3] = wq[81 + 2 * sub];
    wkr[0] = wk[64 + 2 * sub]; wkr[1] = wk[65 + 2 * sub]; wkr[2] = wk[80 + 2 * sub]; wkr[3] = wk[81 + 2 * sub];
    float invf[2];
#pragma unroll
    for (int ii = 0; ii < 2; ++ii) invf[ii] = exp2f(-(float)(2 * sub + ii) * (13.287712379549449f / 16.f));
    constexpr int NT4 = 4;
    for (int tb = gw; tb < T; tb += NGW * NT4) {
        int ps[NT4]; u32x4 qn[NT4], kn[NT4]; unsigned q1[NT4], q2[NT4], k1[NT4], k2[NT4];
#pragma unroll
        for (int k = 0; k < NT4; ++k) {
            const int t = tb + k * NGW;
            ps[k] = pos[t];
            const bf16* qp = Q + (size_t)t * 768 + hh * 96; const bf16* kp = Kp + (size_t)t * 768 + hh * 96;
            qn[k] = *(const u32x4*)(qp + 8 * sub); q1[k] = *(const unsigned*)(qp + 64 + 2 * sub); q2[k] = *(const unsigned*)(qp + 80 + 2 * sub);
            kn[k] = *(const u32x4*)(kp + 8 * sub);
            k1[k] = *(const unsigned*)(P01 + (size_t)t * 512 + 384 + 2 * sub); k2[k] = *(const unsigned*)(P01 + (size_t)t * 512 + 400 + 2 * sub);
        }
#pragma unroll
        for (int k = 0; k < NT4; ++k) {
            const int t = tb + k * NGW;
            const float fp = (float)ps[k];
            float cs[2], sn[2];
#pragma unroll
            for (int ii = 0; ii < 2; ++ii) {
                const float a = fp * invf[ii];
                const float rev = a * 0.15915494309189535f;
                const float err = __builtin_fmaf(a, 0.15915494309189535f, -rev);
                const float fr = (rev - rintf(rev)) + err;
                sn[ii] = __builtin_amdgcn_sinf(fr); cs[ii] = __builtin_amdgcn_cosf(fr);
            }
            {
                bf16* qp = Q + (size_t)t * 768 + hh * 96;
                float f[8]; unpack8(qn[k], f);
                float a1[2] = {bflo(q1[k]), bfhi(q1[k])}, a2[2] = {bflo(q2[k]), bfhi(q2[k])};
                float ss = a1[0] * a1[0] + a1[1] * a1[1] + a2[0] * a2[0] + a2[1] * a2[1];
#pragma unroll
                for (int c = 0; c < 8; ++c) ss += f[c] * f[c];
                ss += __shfl_xor(ss, 1); ss += __shfl_xor(ss, 2); ss += __shfl_xor(ss, 4);
                const float rs = rsqrtf(ss * (1.f / 96.f) + EPS) * C2;
#pragma unroll
                for (int c = 0; c < 8; ++c) f[c] *= rs * wqn[c];
                const float n1a = a1[0] * rs * wqr[0], n1b = a1[1] * rs * wqr[1], n2a = a2[0] * rs * wqr[2], n2b = a2[1] * rs * wqr[3];
                *(u32x4*)(qp + 8 * sub) = pack8(f);
                *(unsigned*)(qp + 64 + 2 * sub) = pk2(n1a * cs[0] - n2a * sn[0], n1b * cs[1] - n2b * sn[1]);
                *(unsigned*)(qp + 80 + 2 * sub) = pk2(n2a * cs[0] + n1a * sn[0], n2b * cs[1] + n1b * sn[1]);
            }
            {
                bf16* kp = Kp + (size_t)t * 768 + hh * 96;
                float f[8]; unpack8(kn[k], f);
                float a1[2] = {bflo(k1[k]), bfhi(k1[k])}, a2[2] = {bflo(k2[k]), bfhi(k2[k])};
                float ss = a1[0] * a1[0] + a1[1] * a1[1] + a2[0] * a2[0] + a2[1] * a2[1];
#pragma unroll
                for (int c = 0; c < 8; ++c) ss += f[c] * f[c];
                ss += __shfl_xor(ss, 1); ss += __shfl_xor(ss, 2); ss += __shfl_xor(ss, 4);
                const float rs = rsqrtf(ss * (1.f / 96.f) + EPS);
#pragma unroll
                for (int c = 0; c < 8; ++c) f[c] *= rs * wkn[c];
                const float n1a = a1[0] * rs * wkr[0], n1b = a1[1] * rs * wkr[1], n2a = a2[0] * rs * wkr[2], n2b = a2[1] * rs * wkr[3];
                *(u32x4*)(kp + 8 * sub) = pack8(f);
                *(unsigned*)(kp + 64 + 2 * sub) = pk2(n1a * cs[0] - n2a * sn[0], n1b * cs[1] - n2b * sn[1]);
                *(unsigned*)(kp + 80 + 2 * sub) = pk2(n2a * cs[0] + n1a * sn[0], n2b * cs[1] + n1b * sn[1]);
            }
        }
    }
}

__device__ __forceinline__ void sg_phase(const Params& p, int o, LAS unsigned char* lds) {
    const int tid = otid(), lane = tid & 63, l15 = lane & 15, l4 = lane >> 4; const int wid = __builtin_amdgcn_readfirstlane(tid >> 6);
    unsigned char* ws = opq(p.ws);
    const bf16* UV = (const bf16*)(ws + A_UV); bf16* UG = (bf16*)(ws + A_UG);
    const bf16* Wsb = (const bf16*)(ws + WS_W + W_SS);
    const float* ssv = (const float*)(ws + A_SSV);
    const float* vnorm = (const float*)p.in[19] + (size_t)o * 2048;
    const float* bs = (const float*)p.in[21] + (size_t)o * 8 * 128;
    constexpr int VP = 272;
    u32x4 vr[8]; f32x4 sv[8];
#define SG_LOAD(task_) do { const int g_ = (task_) & 7; const size_t tk0_ = (size_t)((task_) >> 3) * 128; \
        _Pragma("unroll") for (int i = 0; i < 8; ++i) { const int idx = tid + 512 * i, j = idx & 127, cc = idx >> 7; \
            vr[i] = *(const u32x4*)(UV + (tk0_ + j) * 4096 + 2048 + g_ * 256 + cc * 8); sv[i] = *(const f32x4*)(ssv + ((tk0_ + j) * 8 + g_) * 4); } } while (0)
    if ((int)blockIdx.x < 2048) SG_LOAD(blockIdx.x);
    for (int task = blockIdx.x; task < 2048; task += gridDim.x) {
        const int g = task & 7, chunk = task >> 3; const size_t tok0 = (size_t)chunk * 128;
#pragma unroll
        for (int i = 0; i < 8; ++i) {
            const int idx = tid + 512 * i, j = idx & 127, cc = idx >> 7;
            const float rs = rsqrtf(((sv[i][0] + sv[i][1]) + (sv[i][2] + sv[i][3])) * (1.f / 256.f) + EPS);
            float f[8]; unpack8(vr[i], f);
            const f32x4 n0 = *(const f32x4*)(vnorm + g * 256 + cc * 8), n1 = *(const f32x4*)(vnorm + g * 256 + cc * 8 + 4);
            const float nf[8] = {n0[0], n0[1], n0[2], n0[3], n1[0], n1[1], n1[2], n1[3]};
            LAS unsigned char* d = lds + (cc * 8) * VP + j * 2;
#pragma unroll
            for (int k = 0; k < 8; ++k) *(LAS unsigned short*)(d + k * VP) = (unsigned short)(pk2(f[k] * rs * nf[k], 0.f) & 0xffff);
        }
        if (task + (int)gridDim.x < 2048) SG_LOAD(task + gridDim.x);
        __syncthreads();
        const int nks = (wid >> 1) + 1;
        bf16x8 wf[4];
#pragma unroll
        for (int ks = 0; ks < 4; ++ks) wf[ks] = (ks < nks) ? *(const bf16x8*)(Wsb + ((size_t)(g * 128 + 16 * wid + l15)) * 128 + 32 * ks + 8 * l4) : (bf16x8){0, 0, 0, 0, 0, 0, 0, 0};
        const int irow = 16 * wid + l15;
        const float bsi = bs[g * 128 + irow];
#pragma unroll 4
        for (int ct = 0; ct < 16; ++ct) {
            f32x4 acc = (f32x4){0.f, 0.f, 0.f, 0.f};
#pragma unroll
            for (int ks = 0; ks < 4; ++ks) if (ks < nks) acc = mfma16(lds8(lds, 16 * ct + l15, VP, 32 * ks + 8 * l4), wf[ks], acc);
            *(LAS u32x2*)(lds + 69632 + irow * 528 + (16 * ct + 4 * l4) * 2) = (u32x2){pk2(acc[0] + bsi, acc[1] + bsi), pk2(acc[2] + bsi, acc[3] + bsi)};
        }
        __syncthreads();
#pragma unroll
        for (int k = 0; k < 8; ++k) {
            const int idx = tid + 512 * k, row = idx >> 5, ch = idx & 31;
            const u32x4 gr = *(LAS const u32x4*)(lds + 69632 + row * 528 + ch * 16);
            const u32x4 ur = *(const u32x4*)(UV + (tok0 + row) * 4096 + g * 256 + ch * 8);
            float gf[8], uf[8]; unpack8(gr, gf); unpack8(ur, uf);
#pragma unroll
            for (int c = 0; c < 8; ++c) uf[c] *= gf[c];
            *(u32x4*)(UG + (tok0 + row) * 2048 + g * 256 + ch * 8) = pack8(uf);
        }
    }
#undef SG_LOAD
}

#define XB_TMO      128
#define XB_XCNT(j)  (256  + 64 * (j))
#define XB_XSUB(j)  (1280 + 64 * (j))
#define XB_XGEN(j)  (2304 + 64 * (j))
#define XB_TOP      3328
#define XB_TOPGEN   3392
#define XCD_BAR_WORDS 3456
#define XB_SPIN_CAP (1u << 18)
__device__ __forceinline__ unsigned xb_ld(unsigned* p)              { return __hip_atomic_load(p, __ATOMIC_RELAXED, __HIP_MEMORY_SCOPE_AGENT); }
__device__ __forceinline__ unsigned xb_add(unsigned* p, unsigned v) { return __hip_atomic_fetch_add(p, v, __ATOMIC_RELAXED, __HIP_MEMORY_SCOPE_AGENT); }
__device__ __forceinline__ unsigned xb_xcc_id() { return (unsigned)__builtin_amdgcn_s_getreg((3 << 11) | 20) & 0xFu; }
#define XB_SPIN(cond, bar) do { unsigned _sp = 0; while (cond) { __builtin_amdgcn_s_sleep(1); \
    if ((++_sp & 255u) == 0u) { if (xb_ld(&(bar)[XB_TMO])) break; if (_sp > XB_SPIN_CAP) { atomicAdd(&(bar)[XB_TMO], 1u); break; } } } } while (0)
struct XcdBarrier { unsigned* bar; unsigned x; volatile LAS unsigned* st; };
__device__ __forceinline__ XcdBarrier xcd_barrier_post(unsigned* bar, volatile LAS unsigned* st) {
    XcdBarrier b; b.bar = bar; b.x = xb_xcc_id(); b.st = st;
    if (threadIdx.x == 0) (void)xb_add(&bar[XB_XCNT(b.x)], 1u);
    return b;
}
__device__ __forceinline__ void xcd_barrier_complete(unsigned* bar, unsigned x, unsigned& nloc, unsigned& nx) {
    const unsigned G = gridDim.x * gridDim.y * gridDim.z;
    unsigned sum, cnt, mine, sp = 0u;
    for (;;) {
        sum = 0u; cnt = 0u; mine = 0u;
#pragma unroll
        for (unsigned j = 0; j < 16; ++j) { const unsigned c = xb_ld(&bar[XB_XCNT(j)]); sum += c; cnt += (c > 0u) ? 1u : 0u; mine = (j == x) ? c : mine; }
        if (sum == G) break;
        __builtin_amdgcn_s_sleep(1);
        if ((++sp & 255u) == 0u) { if (xb_ld(&bar[XB_TMO])) break; if (sp > XB_SPIN_CAP) { atomicAdd(&bar[XB_TMO], 1u); break; } }
    }
    nloc = mine > 0u ? mine : 1u; nx = cnt > 0u ? cnt : 1u;
}
__device__ __forceinline__ void xcd_barrier(const XcdBarrier& b) {
    asm volatile("s_waitcnt vmcnt(0)" ::: "memory");
    __syncthreads();
    if (threadIdx.x == 0) {
        unsigned* bar = b.bar;
        __builtin_amdgcn_s_waitcnt(0);
        unsigned nloc = b.st[0], nx = b.st[1];
        if (nloc == 0u) { xcd_barrier_complete(bar, b.x, nloc, nx); b.st[0] = nloc; b.st[1] = nx; }
        const unsigned old = xb_add(&bar[XB_XSUB(b.x)], 1u);
        const unsigned gen = old / nloc;
        if (old + 1u == (gen + 1u) * nloc) {
            __builtin_amdgcn_fence(__ATOMIC_RELEASE, "agent");
            asm volatile("s_waitcnt vmcnt(0)" ::: "memory");
            const unsigned og = xb_add(&bar[XB_TOP], 1u);
            const unsigned tg = og / nx;
            if (og + 1u == (tg + 1u) * nx) xb_add(&bar[XB_TOPGEN], 1u);
            else XB_SPIN(xb_ld(&bar[XB_TOPGEN]) == tg, bar);
            __builtin_amdgcn_fence(__ATOMIC_ACQUIRE, "agent");
            xb_add(&bar[XB_XGEN(b.x)], 1u);
            asm volatile("s_waitcnt vmcnt(0)" ::: "memory");
        } else {
            XB_SPIN(xb_ld(&bar[XB_XGEN(b.x)]) == gen, bar);
            __builtin_amdgcn_fence(__ATOMIC_ACQUIRE, "agent");
            asm volatile("s_waitcnt vmcnt(0)" ::: "memory");
        }
    }
    __syncthreads();
}

__global__ void __launch_bounds__(512, 2) mega_fwd(Params p) {
    extern __shared__ __attribute__((aligned(16))) unsigned char shm[];
    LAS unsigned char* lds = (LAS unsigned char*)shm;
    cg::grid_group grid = cg::this_grid();
    const int G = gridDim.x;
    {
        const int t0 = threadIdx.x;
        if (t0 < 16) ((LAS unsigned*)(lds + LDS_BYTES - 64))[t0] = 0u;
        __syncthreads();
    }
    XcdBarrier xbar = xcd_barrier_post((unsigned*)((float*)(p.ws + WS_CTL) + C_BAR), (volatile LAS unsigned*)(lds + LDS_BYTES - 32));
#define GRID_SYNC() do { xcd_barrier(xbar); if (PROBE_SYNC) xcd_barrier(xbar); } while (0)
#define PH_PTRS unsigned char* ws = opq(p.ws); float* ctl = (float*)(ws + WS_CTL); bf16* xb = (bf16*)(ws + WS_XB); unsigned char* wb = ws + WS_W; (void)ctl; (void)xb; (void)wb;

    {
        PH_PTRS
        const int tid = otid(), lane = tid & 63, wid = tid >> 6, gw = blockIdx.x * 8 + wid, NGW = G * 8;
        const float* x = (const float*)p.in[0];
        for (int mb = gw; mb < T; mb += NGW * 4) {
            f32x4 v[4][4];
#pragma unroll
            for (int k = 0; k < 4; ++k) { const f32x4* xr = (const f32x4*)(x + (size_t)(mb + k * NGW) * DM) + lane;
#pragma unroll
                for (int j = 0; j < 4; ++j) v[k][j] = __builtin_nontemporal_load(xr + 64 * j); }
#pragma unroll
            for (int k = 0; k < 4; ++k) {
                const int m = mb + k * NGW; float s = 0.f;
#pragma unroll
                for (int j = 0; j < 4; ++j) s += (v[k][j][0] * v[k][j][0] + v[k][j][1] * v[k][j][1]) + (v[k][j][2] * v[k][j][2] + v[k][j][3] * v[k][j][3]);
                s = wave_sum(s);
                if (lane < 16) ctl[C_SSX + (size_t)m * 16 + lane] = (lane == 0) ? s : 0.f;
                u32x2* o8 = (u32x2*)(xb + (size_t)m * DM) + lane;
#pragma unroll
                for (int j = 0; j < 4; ++j) o8[64 * j] = (u32x2){pk2(v[k][j][0], v[k][j][1]), pk2(v[k][j][2], v[k][j][3])};
            }
        }
        convert_layer(p, 0, lds);
    }
    if (p.ws == nullptr) grid.sync();
    GRID_SYNC();

    for (int l = 0; l < 4; ++l) {
        const int e = l >> 1;
        if (l > 0) { convert_layer(p, l, lds); if (PROBE_CONV) convert_layer(p, l, lds); GRID_SYNC(); }
        for (int f = 0; f < 2; ++f) {
#ifndef SKIP_MIX
#define SKIP_MIX 0
#endif
            if (f == 1 && !SKIP_MIX) {
                if ((l & 1) == 0) {
                  if (!SKIP_EVEN) {
                    {
                        PH_PTRS
                        pg8::Gemm g{xb, (const bf16*)(wb + W_IN), T, 2560, DM, DM}; pg8::StaticOrder S; S.init(T, 2560, G, blockIdx.x);
                        pg8::EpiInProj E{(bf16*)(ws + A_P01), (bf16*)(ws + A_QKV), (bf16*)(ws + A_Z), ctl + C_SSX, ctl + C_SSQ, ctl + C_SSKV};
                        pg8::gemm_phase(lds, g, S, E);
                        if (PROBE_INP) pg8::gemm_phase(lds, g, S, E);
                    }
                    GRID_SYNC();
                    {
                        PH_PTRS
                        pg8::Gemm g{(const bf16*)(ws + A_P01), (const bf16*)(wb + W_QB), T, 768, 256, 512}; pg8::StaticOrder S; S.init(T, 768, G, blockIdx.x);
                        pg8::EpiQ E{(bf16*)(ws + A_Q), ctl + C_SSQ};
                        pg8::gemm_phase(lds, g, S, E);
                        pg8::Gemm g2{(const bf16*)(ws + A_P01) + 256, (const bf16*)(wb + W_KVB), T, 1024, 256, 512}; pg8::StaticOrder S2; S2.init(T, 1024, G, blockIdx.x);
                        pg8::EpiKV E2{(bf16*)(ws + A_KP), (bf16*)(ws + A_V), ctl + C_SSKV};
                        pg8::gemm_phase(lds, g2, S2, E2);
                        if (PROBE_INP) { pg8::gemm_phase(lds, g, S, E); pg8::gemm_phase(lds, g2, S2, E2); }
                        gdn_pre(p, e);
                        if (PROBE_MISC) gdn_pre(p, e);
                    }
                    GRID_SYNC();
                    {
                        qk_prep(p, e);
                        gdn_prep(p, lds);
                        if (PROBE_MISC) gdn_prep(p, lds);
                    }
                    GRID_SYNC();
                    {
                        PH_PTRS
                        LAS int* qslot = (LAS int*)(lds + LDS_BYTES - 64);
                        for (int rep = 0; rep <= PROBE_E4; ++rep) {
                        int* ctr = (int*)(ctl + C_QCTR) + e * 64 + rep * 32;
                        for (;;) {
                            if (threadIdx.x == 0) *qslot = __hip_atomic_fetch_add(ctr, 1, __ATOMIC_RELAXED, __HIP_MEMORY_SCOPE_AGENT);
                            __syncthreads();
                            const int idx = *qslot;
                            __syncthreads();
                            if (idx >= 32 + 1024) break;
                            if (idx < 32 && ZERO_GDN) {
                                bf16* Yz = (bf16*)(ws + A_Y); const int zb = idx >> 3, zh = idx & 7;
                                const bf16* GQ_ = (const bf16*)(ws + A_GQ); const bf16* GK_ = (const bf16*)(ws + A_GK); const bf16* U_ = (const bf16*)(ws + A_U); const bf16* W_ = (const bf16*)(ws + A_WW); const float* GC_ = (const float*)(ws + A_GC);
                                for (int i = threadIdx.x; i < SEQ * 8; i += 512) { const int tk = i >> 3, sgm = i & 7; const size_t tok = (size_t)zb * SEQ + tk; const int nn = tk >> 6, rr = tk & 63;
                                    float a[8], b_[8], c_[8], d_[8], o_[8];
                                    unpack8(*(const u32x4*)(GQ_ + tok * 512 + zh * 64 + sgm * 8), a); unpack8(*(const u32x4*)(GK_ + tok * 512 + zh * 64 + sgm * 8), b_);
                                    unpack8(*(const u32x4*)(U_ + (((size_t)idx * 128 + nn) * 64 + rr) * 64 + sgm * 8), c_); unpack8(*(const u32x4*)(W_ + (((size_t)idx * 128 + nn) * 64 + rr) * 64 + sgm * 8), d_);
                                    const float gcv = GC_[((size_t)idx * 128 + nn) * 64 + rr]; unpack8(*(const u32x4*)((const bf16*)(ws + A_Z) + tok * 512 + zh * 64 + sgm * 8), a);
                                    for (int k = 0; k < 8; ++k) o_[k] = a[k] + b_[k] + c_[k] + d_[k] + 0.01f * gcv;
                                    *(u32x4*)(Yz + tok * 1024 + 512 + zh * 64 + sgm * 8) = pack8(o_); }
                            } else if (idx < 32) {
                                gdn_scan(lds, idx, (const bf16*)(ws + A_GQ), (const bf16*)(ws + A_GK), (const bf16*)(ws + A_U), (const bf16*)(ws + A_WW), (const float*)(ws + A_GC),
                                         (const bf16*)(ws + A_Z), (const float*)p.in[16] + e * 64, (bf16*)(ws + A_Y));
                            } else {
                                const int a = idx - 32, qb = 31 - (a >> 5), bh = a & 31;
                                if (ZERO_ATT) { bf16* Yz = (bf16*)(ws + A_Y); for (int i = threadIdx.x; i < 256 * 8; i += 512) { const int tk = i >> 3, sgm = i & 7; *(u32x4*)(Yz + ((size_t)(bh >> 3) * SEQ + qb * 256 + tk) * 1024 + (bh & 7) * 64 + sgm * 8) = (u32x4){0u, 0u, 0u, 0u}; } }
                                else attn_unit(lds, (const bf16*)(ws + A_Q), (const bf16*)(ws + A_KP), (const bf16*)(ws + A_V), (bf16*)(ws + A_Y), bh >> 3, bh & 7, qb);
                            }
                        }
                        }
                    }
                    GRID_SYNC();
                    {
                        PH_PTRS
                        pg8::Gemm g{(const bf16*)(ws + A_Y), (const bf16*)(wb + W_OUT), T, DM, DM, DM}; pg8::StaticOrder S; S.init(T, DM, G, blockIdx.x);
                        pg8::EpiResid E{xb, nullptr, ctl + C_SSX, 1.f};
                        pg8::gemm_phase(lds, g, S, E);
                    }
                    GRID_SYNC();
                  }
                } else {
                    {
                        PH_PTRS
                        pg8::Gemm g{xb, (const bf16*)(wb + W_SIN), T, 4096, DM, DM}; pg8::StaticOrder S; S.init(T, 4096, G, blockIdx.x);
                        pg8::EpiSgIn E{(bf16*)(ws + A_UV), ctl + C_SSX, (float*)(ws + A_SSV)};
                        pg8::gemm_phase(lds, g, S, E);
                        if (PROBE_INP) pg8::gemm_phase(lds, g, S, E);
                    }
                    GRID_SYNC();
                    sg_phase(p, e, lds);
                    if (PROBE_SG) sg_phase(p, e, lds);
                    GRID_SYNC();
                    {
                        PH_PTRS
                        pg8::Gemm g{(const bf16*)(ws + A_UG), (const bf16*)(wb + W_SOUT), T, DM, 2048, 2048}; pg8::StaticOrder S; S.init(T, DM, G, blockIdx.x);
                        pg8::EpiResid E{xb, nullptr, ctl + C_SSX, 1.f};
                        pg8::gemm_phase(lds, g, S, E);
                    }
                    GRID_SYNC();
                }
            }
            {
                        PH_PTRS
                pg8::Gemm g{xb, (const bf16*)(wb + (f == 0 ? W_1A : W_1B)), T, 2 * FF, DM, DM}; pg8::StaticOrder S; S.init(T, 2 * FF, G, blockIdx.x);
                pg8::EpiSwiglu E{(bf16*)(ws + A_H), ctl + C_SSX};
                pg8::gemm_phase(lds, g, S, E);
                if (PROBE_G1) pg8::gemm_phase(lds, g, S, E);
            }
            GRID_SYNC();
            {
                        PH_PTRS
                pg8::Gemm g{(const bf16*)(ws + A_H), (const bf16*)(wb + (f == 0 ? W_2A : W_2B)), T, DM, FF, FF}; pg8::StaticOrder S; S.init(T, DM, G, blockIdx.x);
                const bool lastg = (l == 3 && f == 1);
                pg8::EpiResid E{xb, lastg ? p.out : nullptr, lastg ? nullptr : ctl + C_SSX, 0.5f};
                pg8::gemm_phase(lds, g, S, E);
            }
            if (!(l == 3 && f == 1)) GRID_SYNC();
        }
    }
}

extern "C" void kernel_launch(void* const* d_in, const int* in_sizes, int n_in, void* d_out, int out_size, void* d_ws, size_t ws_size, hipStream_t stream) {
    static int grid = 0;
    if (grid == 0) {
        if (n_in != 23 || ws_size < WS_END) { fprintf(stderr, "kernel_launch: unexpected n_in %d or ws_size %zu\n", n_in, ws_size); grid = -1; return; }
        int dev = 0, cus = 0, per_cu = 0;
        hipGetDevice(&dev);
        hipDeviceGetAttribute(&cus, hipDeviceAttributeMultiprocessorCount, dev);
        if (hipFuncSetAttribute((const void*)mega_fwd, hipFuncAttributeMaxDynamicSharedMemorySize, LDS_BYTES) != hipSuccess) { fprintf(stderr, "kernel_launch: hipFuncSetAttribute failed\n"); grid = -1; return; }
        if (hipOccupancyMaxActiveBlocksPerMultiprocessor(&per_cu, (const void*)mega_fwd, 512, LDS_BYTES) != hipSuccess || per_cu < 1) { fprintf(stderr, "kernel_launch: occupancy query says %d\n", per_cu); per_cu = 1; }
        (void)hipGetLastError();
        grid = cus * 1;
    }
    if (grid < 0) return;
    if (hipMemsetAsync((char*)d_ws + WS_CTL + (size_t)C_BAR * 4, 0, 32768, stream) != hipSuccess) { fprintf(stderr, "kernel_launch: memset failed\n"); return; }
    Params p{};
    for (int i = 0; i < 23; ++i) p.in[i] = d_in[i];
    p.out = (float*)d_out; p.ws = (unsigned char*)d_ws;
    void* args[] = {&p};
    hipError_t e = hipLaunchCooperativeKernel((const void*)mega_fwd, dim3(grid), dim3(512), args, LDS_BYTES, stream);
    if (e != hipSuccess) fprintf(stderr, "cooperative launch failed: %s (grid %d)\n", hipGetErrorString(e), grid);
}
```
